# Optimizing an MI355X kernel written in HIP

```python
import math
import jax, jax.numpy as jnp
from jax import lax
import numpy as np

D_MODEL = 1024
BATCH = 4
SEQ = 8192
DEPTH = 1

HEAD_DIM = 64
HEADS_PER_GROUP = 4
DILATED_GROUPS = ((128, 1), (512, 4), (2048, 16))
N_ATTN_GROUPS = len(DILATED_GROUPS)
N_ATTN_HEADS = N_ATTN_GROUPS * HEADS_PER_GROUP
ATTN_WIDTH = N_ATTN_HEADS * HEAD_DIM
ATTN_OUT_WIDTH = HEADS_PER_GROUP * HEAD_DIM
BLOCK = 128
N_BUCKETS = 32
MAX_DISTANCE = 2048
NEG_INF = -1e30
SSM_GROUP = 16
SSM_WIDTH = 512
SSM_GROUPS = SSM_WIDTH // SSM_GROUP
SSM_STATE = 64
DT_MIN = 1e-3
DT_MAX = 1e-1
D_FF = 2816
EPS = 1e-6
IN_WIDTH = 3 * ATTN_WIDTH + SSM_WIDTH + 2 * D_MODEL

kernel_name = "hybrid_dilated_attn_s5_macaron"


def rms_norm(x, g):
    xf = x.astype(jnp.float32)
    y = xf * lax.rsqrt(jnp.mean(xf * xf, axis=-1, keepdims=True) + EPS)
    return (y * g.astype(jnp.float32)).astype(x.dtype)


def swiglu(h, w_gate, w_up, w_down):
    return (jax.nn.silu(h @ w_gate) * (h @ w_up)) @ w_down


def t5_bucket(dist):
    max_exact = N_BUCKETS // 2
    d = jnp.maximum(dist, 1).astype(jnp.float32)
    large = max_exact + (jnp.log(d / max_exact) / math.log(MAX_DISTANCE / max_exact)
                         * (N_BUCKETS - max_exact)).astype(jnp.int32)
    large = jnp.minimum(large, N_BUCKETS - 1)
    return jnp.where(dist < max_exact, dist, large)


def dilated_group_attention(q, k, v, bias_table_g, window, dilation):
    B, L, H, Dh = q.shape
    M = L // dilation
    n_steps = window // dilation
    nb = -(-M // BLOCK)
    Mp = nb * BLOCK

    def to_sub(t):
        t = t.reshape(B, M, dilation, H, Dh).transpose(0, 2, 1, 3, 4).reshape(B * dilation, M, H, Dh)
        t = jnp.pad(t, ((0, 0), (0, Mp - M), (0, 0), (0, 0)))
        return t.reshape(B * dilation, nb, BLOCK, H, Dh)

    def with_prev(t):
        prev = jnp.pad(t, ((0, 0), (1, 0), (0, 0), (0, 0), (0, 0)))[:, :-1]
        return jnp.concatenate([prev, t], axis=2)

    qs = to_sub(q).astype(jnp.float32)
    kb = with_prev(to_sub(k)).astype(jnp.float32)
    vb = with_prev(to_sub(v)).astype(jnp.float32)

    qi = jnp.arange(BLOCK)[:, None]
    kj = jnp.arange(2 * BLOCK)[None, :]
    steps = qi + BLOCK - kj
    band = (steps >= 0) & (steps <= n_steps)
    first_ok = (jnp.arange(nb)[:, None] > 0) | (kj >= BLOCK)
    mask = band[None] & first_ok[:, None, :]
    bucket = t5_bucket(jnp.maximum(steps, 0) * dilation)
    bias = bias_table_g.astype(jnp.float32)[bucket].transpose(2, 0, 1)

    logits = jnp.einsum('bnqhd,bnkhd->bhnqk', qs, kb) + bias[None, :, None]
    logits = jnp.where(mask[None, None], logits, NEG_INF)
    m = jnp.max(logits, axis=-1, keepdims=True)
    p = jnp.exp(logits - m)
    denom = jnp.sum(p, axis=-1)
    o = jnp.einsum('bhnqk,bnkhd->bnqhd', p, vb) / denom.transpose(0, 2, 3, 1)[..., None]
    lse = m[..., 0] + jnp.log(denom)

    o = o.reshape(B * dilation, Mp, H, Dh)[:, :M]
    o = o.reshape(B, dilation, M, H, Dh).transpose(0, 2, 1, 3, 4).reshape(B, L, H, Dh)
    lse = lse.transpose(0, 2, 3, 1).reshape(B * dilation, Mp, H)[:, :M]
    lse = lse.reshape(B, dilation, M, H).transpose(0, 2, 1, 3).reshape(B, L, H)
    return o, lse


def s5_mixer(u, a_re, a_im, log_dt, b_re, b_im, c_re, c_im, d_skip):
    B, L, _ = u.shape
    uf = u.astype(jnp.float32).reshape(B, L, SSM_GROUPS, SSM_GROUP)
    lam_re = a_re.astype(jnp.float32)
    lam_im = a_im.astype(jnp.float32)
    dt = jnp.exp(log_dt.astype(jnp.float32))[:, None]
    mag = jnp.exp(lam_re * dt)
    ab_re = mag * jnp.cos(lam_im * dt)
    ab_im = mag * jnp.sin(lam_im * dt)
    den = lam_re * lam_re + lam_im * lam_im
    xr = ab_re - 1.0
    coef_re = (xr * lam_re + ab_im * lam_im) / den
    coef_im = (ab_im * lam_re - xr * lam_im) / den
    br = b_re.astype(jnp.float32)
    bi = b_im.astype(jnp.float32)
    bb_re = coef_re[..., None] * br - coef_im[..., None] * bi
    bb_im = coef_re[..., None] * bi + coef_im[..., None] * br
    bu_re = jnp.einsum('gnc,blgc->lbgn', bb_re, uf)
    bu_im = jnp.einsum('gnc,blgc->lbgn', bb_im, uf)
    a_seq_re = jnp.broadcast_to(ab_re[None, None], (L, 1, SSM_GROUPS, SSM_STATE))
    a_seq_im = jnp.broadcast_to(ab_im[None, None], (L, 1, SSM_GROUPS, SSM_STATE))

    def combine(left, right):
        al_re, al_im, bl_re, bl_im = left
        ar_re, ar_im, brr, bri = right
        return (al_re * ar_re - al_im * ar_im,
                al_re * ar_im + al_im * ar_re,
                ar_re * bl_re - ar_im * bl_im + brr,
                ar_re * bl_im + ar_im * bl_re + bri)

    _, _, s_re, s_im = lax.associative_scan(combine, (a_seq_re, a_seq_im, bu_re, bu_im), axis=0)
    y = (jnp.einsum('gcn,lbgn->blgc', c_re.astype(jnp.float32), s_re)
         - jnp.einsum('gcn,lbgn->blgc', c_im.astype(jnp.float32), s_im)
         + d_skip.astype(jnp.float32).reshape(SSM_GROUPS, SSM_GROUP) * uf)
    return y.reshape(B, L, SSM_WIDTH).astype(u.dtype)


def setup_inputs(seed: int = 0) -> dict:
    key = jax.random.key(seed)
    ks = iter(jax.random.split(key, 32))
    f32 = jnp.float32

    def nrm(shape, scale):
        return jax.random.normal(next(ks), shape, f32) * scale

    def gain(shape):
        return 1.0 + 0.05 * jax.random.normal(next(ks), shape, f32)

    L_ = DEPTH
    n_idx = jnp.arange(SSM_STATE, dtype=f32)
    return {
        "x": jax.random.normal(next(ks), (BATCH, SEQ, D_MODEL), f32),
        "ffn1_norm": gain((L_, D_MODEL)),
        "ffn1_w_gate": nrm((L_, D_MODEL, D_FF), D_MODEL ** -0.5),
        "ffn1_w_up": nrm((L_, D_MODEL, D_FF), D_MODEL ** -0.5),
        "ffn1_w_down": nrm((L_, D_FF, D_MODEL), D_FF ** -0.5),
        "mix_norm": gain((L_, D_MODEL)),
        "w_in": nrm((L_, D_MODEL, IN_WIDTH), D_MODEL ** -0.5),
        "gate_bias": nrm((L_, 2 * D_MODEL), 0.1),
        "rel_bias_table": nrm((N_BUCKETS, N_ATTN_HEADS), 0.5),
        "ssm_a_re": -0.5 + nrm((L_, SSM_GROUPS, SSM_STATE), 0.01),
        "ssm_a_im": math.pi * n_idx + nrm((L_, SSM_GROUPS, SSM_STATE), 0.01),
        "ssm_log_dt": jax.random.uniform(next(ks), (L_, SSM_GROUPS), f32,
                                         math.log(DT_MIN), math.log(DT_MAX)),
        "ssm_b_re": nrm((L_, SSM_GROUPS, SSM_STATE, SSM_GROUP), (2 * SSM_GROUP) ** -0.5),
        "ssm_b_im": nrm((L_, SSM_GROUPS, SSM_STATE, SSM_GROUP), (2 * SSM_GROUP) ** -0.5),
        "ssm_c_re": nrm((L_, SSM_GROUPS, SSM_GROUP, SSM_STATE), (2 * SSM_STATE) ** -0.5),
        "ssm_c_im": nrm((L_, SSM_GROUPS, SSM_GROUP, SSM_STATE), (2 * SSM_STATE) ** -0.5),
        "ssm_d": nrm((L_, SSM_WIDTH), 1.0),
        "ssm_w_glu": nrm((L_, SSM_WIDTH, 2 * SSM_WIDTH), SSM_WIDTH ** -0.5),
        "w_attn_branch": nrm((L_, ATTN_OUT_WIDTH, D_MODEL), ATTN_OUT_WIDTH ** -0.5),
        "w_ssm_branch": nrm((L_, SSM_WIDTH, D_MODEL), SSM_WIDTH ** -0.5),
        "w_out": nrm((L_, D_MODEL, D_MODEL), D_MODEL ** -0.5),
        "ffn2_norm": gain((L_, D_MODEL)),
        "ffn2_w_gate": nrm((L_, D_MODEL, D_FF), D_MODEL ** -0.5),
        "ffn2_w_up": nrm((L_, D_MODEL, D_FF), D_MODEL ** -0.5),
        "ffn2_w_down": nrm((L_, D_FF, D_MODEL), D_FF ** -0.5),
        "final_norm": gain((D_MODEL,)),
    }


def reference(x, ffn1_norm, ffn1_w_gate, ffn1_w_up, ffn1_w_down, mix_norm, w_in, gate_bias,
              rel_bias_table, ssm_a_re, ssm_a_im, ssm_log_dt, ssm_b_re, ssm_b_im, ssm_c_re,
              ssm_c_im, ssm_d, ssm_w_glu, w_attn_branch, w_ssm_branch, w_out, ffn2_norm,
              ffn2_w_gate, ffn2_w_up, ffn2_w_down, final_norm):
    B, L, _ = x.shape
    scale = HEAD_DIM ** -0.5
    for l in range(DEPTH):
        x = x + 0.5 * swiglu(rms_norm(x, ffn1_norm[l]), ffn1_w_gate[l], ffn1_w_up[l], ffn1_w_down[l])

        h = rms_norm(x, mix_norm[l])
        z = h @ w_in[l]
        c0 = ATTN_WIDTH
        q = z[..., :c0].reshape(B, L, N_ATTN_HEADS, HEAD_DIM) * scale
        k = z[..., c0:2 * c0].reshape(B, L, N_ATTN_HEADS, HEAD_DIM)
        v = z[..., 2 * c0:3 * c0].reshape(B, L, N_ATTN_HEADS, HEAD_DIM)
        c1 = 3 * c0
        u = z[..., c1:c1 + SSM_WIDTH]
        c2 = c1 + SSM_WIDTH
        g_attn = jax.nn.sigmoid(z[..., c2:c2 + D_MODEL] + gate_bias[l, :D_MODEL])
        g_ssm = jax.nn.sigmoid(z[..., c2 + D_MODEL:] + gate_bias[l, D_MODEL:])

        outs, lses = [], []
        for g, (window, dilation) in enumerate(DILATED_GROUPS):
            hs = slice(g * HEADS_PER_GROUP, (g + 1) * HEADS_PER_GROUP)
            o_g, lse_g = dilated_group_attention(q[:, :, hs], k[:, :, hs], v[:, :, hs],
                                                 rel_bias_table[:, hs], window, dilation)
            outs.append(o_g)
            lses.append(lse_g)
        o_stack = jnp.stack(outs, axis=2)
        w_grp = jax.nn.softmax(jnp.stack(lses, axis=2), axis=2)
        o_attn = jnp.sum(w_grp[..., None] * o_stack, axis=2).reshape(B, L, ATTN_OUT_WIDTH)
        y_attn = o_attn.astype(x.dtype) @ w_attn_branch[l]

        y_s = jax.nn.gelu(s5_mixer(u, ssm_a_re[l], ssm_a_im[l], ssm_log_dt[l], ssm_b_re[l],
                                   ssm_b_im[l], ssm_c_re[l], ssm_c_im[l], ssm_d[l]))
        glu = y_s @ ssm_w_glu[l]
        y_s = glu[..., :SSM_WIDTH] * jax.nn.sigmoid(glu[..., SSM_WIDTH:])
        y_ssm = y_s @ w_ssm_branch[l]

        x = x + (g_attn * y_attn + g_ssm * y_ssm) @ w_out[l]

        x = x + 0.5 * swiglu(rms_norm(x, ffn2_norm[l]), ffn2_w_gate[l], ffn2_w_up[l], ffn2_w_down[l])
    return rms_norm(x, final_norm)
```

```cpp
#include <hip/hip_runtime.h>
#include <hip/hip_cooperative_groups.h>
#include <cstdio>
#include <cstdint>
#include <cmath>
namespace cg = cooperative_groups;
#ifndef ONE_LAUNCH
#define ONE_LAUNCH 1
#endif
namespace pg8 {
#define PG8_LAS __attribute__((address_space(3)))
typedef unsigned short bf16_t;
typedef short bf16x8 __attribute__((ext_vector_type(8)));
typedef float f32x4 __attribute__((ext_vector_type(4)));
typedef unsigned u32x4 __attribute__((ext_vector_type(4)));
constexpr int BM = 256, BK = 64, HALF = 128, HTB = HALF * BK * 2  , STAGE_BYTES = 8 * HTB, NXCD = 8, WGM = 8;

__host__ __device__ __forceinline__ int lds_byte(int r, int c) { const int st = (r >> 4) * 2 + (c >> 5), rr = r & 15, cc = c & 31, ob = rr * 64 + cc * 2; return st * 1024 + (ob ^ (((ob >> 9) & 1) << 5)); }
__host__ __device__ __forceinline__ void stage_rc(int b, int& R, int& C) { const int st = b / 1024, sb = b % 1024, swz = sb ^ (((sb >> 9) & 1) << 5); R = (st >> 1) * 16 + swz / 64; C = (st & 1) * 32 + (swz % 64) / 2; }
__host__ __device__ __forceinline__ int perm32(int rho) { const int n = rho >> 4, i = rho & 15; return 8 * (i >> 2) + 4 * n + (i & 3); }

struct Unit { int pm, pn; };
struct Gemm { const bf16_t* A; const bf16_t* Bt; int M, N, K; };

struct StaticOrder {
    int nM, nN, nwg, G, c;
    __host__ __device__ void init(int M, int N, int G_, int c_) { nM = M / BM; nN = N / BM; nwg = nM * nN; G = G_; c = c_; }
    __host__ __device__ bool next(int i, Unit& u) const {
        const long L = (long)i * G + c; if (L >= nwg) return false;
        int wgid = (int)L; { const int q = nwg / NXCD, r = nwg % NXCD, xcd = wgid % NXCD, off = wgid / NXCD; wgid = (xcd < r ? xcd * (q + 1) : r * (q + 1) + (xcd - r) * q) + off; }
        const int nig = WGM * nN, gid = wgid / nig, fm = gid * WGM, gsz = (nM - fm) < WGM ? (nM - fm) : WGM;
        u.pm = fm + ((wgid % nig) % gsz); u.pn = (wgid % nig) / gsz; return true;
    }
    __device__ __forceinline__ void a_ready(const Unit&) const {}
    __device__ __forceinline__ void done(const Unit&) const {}
};


constexpr float RMS_EPS = 1e-6f;
constexpr int TOK = 32768, DM = 1024, SEQL = 8192;
__device__ __forceinline__ unsigned cvt_pk_bf16(float lo, float hi) { unsigned r; asm volatile("v_cvt_pk_bf16_f32 %0, %1, %2" : "=v"(r) : "v"(lo), "v"(hi)); return r; }
__device__ __forceinline__ u32x4 pack8(const f32x4& a, const f32x4& b) { u32x4 w; w.x = cvt_pk_bf16(a[0], a[1]); w.y = cvt_pk_bf16(a[2], a[3]); w.z = cvt_pk_bf16(b[0], b[1]); w.w = cvt_pk_bf16(b[2], b[3]); return w; }
__device__ __forceinline__ float bf_lo(unsigned w) { return __uint_as_float(w << 16); }
__device__ __forceinline__ float bf_hi(unsigned w) { return __uint_as_float(w & 0xffff0000u); }
__device__ __forceinline__ void unpack8(const u32x4& w, f32x4& a, f32x4& b) { a = (f32x4){bf_lo(w.x), bf_hi(w.x), bf_lo(w.y), bf_hi(w.y)}; b = (f32x4){bf_lo(w.z), bf_hi(w.z), bf_lo(w.w), bf_hi(w.w)}; }
__device__ __forceinline__ float sigm(float x) { return __builtin_amdgcn_rcpf(1.f + __expf(-x)); }
__device__ __forceinline__ f32x4 sigm4(const f32x4& x) { return (f32x4){sigm(x[0]), sigm(x[1]), sigm(x[2]), sigm(x[3])}; }
__device__ __forceinline__ float row_rs(const float* ss, int row) { return ss ? __builtin_amdgcn_rsqf(ss[row] * (1.0f / 1024.0f) + RMS_EPS) : 1.0f; }

struct EpiSwiglu {
    static constexpr bool PERM = true, AFTER_DRAIN = false;
    bf16_t* O; int ldo; const float* ss;
    __device__ __forceinline__ void operator()(const f32x4 (&acc)[2][2][4][2], const Unit& u, int wr, int wc, int fr, int fq) const {
        const int col0 = u.pn * 128 + wc * 32 + 8 * fq;
#pragma unroll
        for (int ai = 0; ai < 2; ++ai)
#pragma unroll
            for (int m = 0; m < 4; ++m) {
                const int row = u.pm * BM + ai * HALF + wr * 64 + m * 16 + fr; const float rs = row_rs(ss, row);
                f32x4 o[2];
#pragma unroll
                for (int n = 0; n < 2; ++n) { const f32x4 g = acc[ai][0][m][n] * rs, up = acc[ai][1][m][n] * rs; o[n] = g * sigm4(g) * up; }
                *(u32x4*)(O + (size_t)row * ldo + col0) = pack8(o[0], o[1]);
            }
    }
};
struct EpiResid {
    static constexpr bool PERM = true, AFTER_DRAIN = false;
    const float* base; float* out; bf16_t* xb; float* ss; float alpha;
    __device__ __forceinline__ void operator()(const f32x4 (&acc)[2][2][4][2], const Unit& u, int wr, int wc, int fr, int fq) const {
        const int col0 = u.pn * BM + wc * 32 + 8 * fq;
#pragma unroll
        for (int ai = 0; ai < 2; ++ai)
#pragma unroll
            for (int m = 0; m < 4; ++m) {
                const int row = u.pm * BM + ai * HALF + wr * 64 + m * 16 + fr; float sq = 0.f;
#pragma unroll
                for (int bj = 0; bj < 2; ++bj) {
                    const size_t off = (size_t)row * DM + col0 + bj * HALF;
                    const f32x4 b0 = *(const f32x4*)(base + off), b1 = *(const f32x4*)(base + off + 4);
                    const f32x4 x0 = b0 + acc[ai][bj][m][0] * alpha, x1 = b1 + acc[ai][bj][m][1] * alpha;
                    *(f32x4*)(out + off) = x0; *(f32x4*)(out + off + 4) = x1;
                    if (xb) *(u32x4*)(xb + off) = pack8(x0, x1);
                    sq += (x0[0] * x0[0] + x0[1] * x0[1]) + (x0[2] * x0[2] + x0[3] * x0[3]) + (x1[0] * x1[0] + x1[1] * x1[1]) + (x1[2] * x1[2] + x1[3] * x1[3]);
                }
                if (ss) { sq += __shfl_xor(sq, 16); sq += __shfl_xor(sq, 32); if (fq == 0) unsafeAtomicAdd(ss + row, sq); }
                asm volatile("" ::: "memory");
            }
    }
};
struct EpiZ {
    static constexpr bool PERM = true, AFTER_DRAIN = false;
    bf16_t *Q, *K, *Vt, *U, *G; const float* ss; const float* gbias;
    __device__ __forceinline__ void operator()(const f32x4 (&acc)[2][2][4][2], const Unit& u, int wr, int wc, int fr, int fq) const {
        const int pn = u.pn;
#pragma unroll
        for (int ai = 0; ai < 2; ++ai)
#pragma unroll
            for (int m = 0; m < 4; ++m) {
                const int row = u.pm * BM + ai * HALF + wr * 64 + m * 16 + fr; const float rs = row_rs(ss, row);
                const int b = row >> 13, tt = row & (SEQL - 1);
#pragma unroll
                for (int bj = 0; bj < 2; ++bj) {
                    f32x4 z0 = acc[ai][bj][m][0] * rs, z1 = acc[ai][bj][m][1] * rs;
                    const int ct = bj * HALF + wc * 32 + 8 * fq;
                    if (pn < 9) {
                        const int seg = pn / 3, cs = (pn - seg * 3) * BM + ct, h = cs >> 6, dd0 = cs & 63, sh = 2 * (h >> 2);
                        const int tp = ((tt & ((1 << sh) - 1)) << (13 - sh)) + (tt >> sh);
                        const size_t bh = (size_t)(b * 12 + h);
                        if (seg == 0) { z0 = z0 * 0.125f; z1 = z1 * 0.125f; *(u32x4*)(Q + (bh * SEQL + tp) * 64 + dd0) = pack8(z0, z1); }
                        else if (seg == 1) { *(u32x4*)(K + (bh * SEQL + tp) * 64 + dd0) = pack8(z0, z1); }
                        else { const u32x4 w = pack8(z0, z1); bf16_t* vp = Vt + (bh * 64 + dd0) * SEQL + tp;
                            vp[0 * SEQL] = (bf16_t)(w.x & 0xffffu); vp[1 * SEQL] = (bf16_t)(w.x >> 16); vp[2 * SEQL] = (bf16_t)(w.y & 0xffffu); vp[3 * SEQL] = (bf16_t)(w.y >> 16);
                            vp[4 * SEQL] = (bf16_t)(w.z & 0xffffu); vp[5 * SEQL] = (bf16_t)(w.z >> 16); vp[6 * SEQL] = (bf16_t)(w.w & 0xffffu); vp[7 * SEQL] = (bf16_t)(w.w >> 16); }
                    } else if (pn < 11) {
                        *(u32x4*)(U + (size_t)row * 512 + (pn - 9) * BM + ct) = pack8(z0, z1);
                    } else {
                        const int cg_ = (pn - 11) * BM + ct;
                        const f32x4 g0 = *(const f32x4*)(gbias + cg_), g1 = *(const f32x4*)(gbias + cg_ + 4);
                        z0 = sigm4(z0 + g0); z1 = sigm4(z1 + g1);
                        *(u32x4*)(G + (size_t)row * 2048 + cg_) = pack8(z0, z1);
                    }
                }
            }
    }
};
struct EpiGateMul {
    static constexpr bool PERM = true, AFTER_DRAIN = false;
    bf16_t* O; const bf16_t* Gt;
    __device__ __forceinline__ void operator()(const f32x4 (&acc)[2][2][4][2], const Unit& u, int wr, int wc, int fr, int fq) const {
        const int col0 = u.pn * BM + wc * 32 + 8 * fq;
#pragma unroll
        for (int ai = 0; ai < 2; ++ai)
#pragma unroll
            for (int m = 0; m < 4; ++m) {
                const int row = u.pm * BM + ai * HALF + wr * 64 + m * 16 + fr;
#pragma unroll
                for (int bj = 0; bj < 2; ++bj) {
                    const int c = col0 + bj * HALF; f32x4 g0, g1; unpack8(*(const u32x4*)(Gt + (size_t)row * 2048 + c), g0, g1);
                    *(u32x4*)(O + (size_t)row * DM + c) = pack8(acc[ai][bj][m][0] * g0, acc[ai][bj][m][1] * g1);
                }
                asm volatile("" ::: "memory");
            }
    }
};
struct EpiGlu {
    static constexpr bool PERM = true, AFTER_DRAIN = false;
    bf16_t* O;
    __device__ __forceinline__ void operator()(const f32x4 (&acc)[2][2][4][2], const Unit& u, int wr, int wc, int fr, int fq) const {
        const int col0 = u.pn * 128 + wc * 32 + 8 * fq;
#pragma unroll
        for (int ai = 0; ai < 2; ++ai)
#pragma unroll
            for (int m = 0; m < 4; ++m) {
                const int row = u.pm * BM + ai * HALF + wr * 64 + m * 16 + fr;
                *(u32x4*)(O + (size_t)row * 512 + col0) = pack8(acc[ai][0][m][0] * sigm4(acc[ai][1][m][0]), acc[ai][0][m][1] * sigm4(acc[ai][1][m][1]));
            }
    }
};
struct EpiMerge {
    static constexpr bool PERM = true, AFTER_DRAIN = false;
    bf16_t* O; const bf16_t* M1; const bf16_t* Gt;
    __device__ __forceinline__ void operator()(const f32x4 (&acc)[2][2][4][2], const Unit& u, int wr, int wc, int fr, int fq) const {
        const int col0 = u.pn * BM + wc * 32 + 8 * fq;
#pragma unroll
        for (int ai = 0; ai < 2; ++ai)
#pragma unroll
            for (int m = 0; m < 4; ++m) {
                const int row = u.pm * BM + ai * HALF + wr * 64 + m * 16 + fr;
#pragma unroll
                for (int bj = 0; bj < 2; ++bj) {
                    const int c = col0 + bj * HALF; f32x4 g0, g1, a0, a1;
                    unpack8(*(const u32x4*)(Gt + (size_t)row * 2048 + c), g0, g1); unpack8(*(const u32x4*)(M1 + (size_t)row * DM + c), a0, a1);
                    *(u32x4*)(O + (size_t)row * DM + c) = pack8(a0 + acc[ai][bj][m][0] * g0, a1 + acc[ai][bj][m][1] * g1);
                }
                asm volatile("" ::: "memory");
            }
    }
};

template <class Epi, class Sched, bool ALIGN_EPI = false, bool SP2 = false>
__device__ __forceinline__ void gemm_phase(PG8_LAS unsigned char* lds, const Gemm g, const Sched& S, const Epi& E) {
    int tid_ = threadIdx.x; asm volatile("" : "+v"(tid_) :: "memory");
    const int tid = tid_, wid = __builtin_amdgcn_readfirstlane(tid >> 6), lane = tid & 63, wr = wid >> 2, wc = wid & 3, fr = lane & 15, fq = lane >> 4;
    const int K = g.K, nt = K / BK;
    unsigned voffA[2], voffB[2];
#pragma unroll
    for (int i = 0; i < 2; ++i) { int R, C; stage_rc(tid * 16 + i * 8192, R, C); const int Rb = Epi::PERM ? ((R & ~31) + perm32(R & 31)) : R;
        voffA[i] = (unsigned)(R * K + C) * 2u; voffB[i] = (unsigned)(Rb * K + C) * 2u; }
    const size_t kstep = (size_t)(BK * 2);
    const size_t hstep = (size_t)HALF * K * 2;
    const size_t tstep = 2 * hstep;
    const unsigned ldsw = (unsigned)wid * 1024u;
    const int aoff = lds_byte(wr * 64 + fr, fq * 8), boff = lds_byte(wc * 32 + fr, fq * 8);
#define PG8_SA(b, h) (((b) * 2 + (h)) * HTB)
#define PG8_SB(b, h) ((4 + (b) * 2 + (h)) * HTB)
#define PG8_STAGE(bufoff, gbase, voff) do { _Pragma("unroll") for (int _i = 0; _i < 2; ++_i) \
        __builtin_amdgcn_global_load_lds((const unsigned*)((const char*)(gbase) + (voff)[_i]), (PG8_LAS unsigned*)(lds + (bufoff) + ldsw + _i * 8192), 16, 0, 0); } while (0)
#define PG8_LDA(dst, b, h) do { _Pragma("unroll") for (int m = 0; m < 4; ++m) _Pragma("unroll") for (int k = 0; k < 2; ++k) dst[m][k] = *(const PG8_LAS bf16x8*)(lds + PG8_SA(b, h) + aoff + m * 2048 + k * 1024); } while (0)
#define PG8_LDB(dst, b, h) do { _Pragma("unroll") for (int n = 0; n < 2; ++n) _Pragma("unroll") for (int k = 0; k < 2; ++k) dst[n][k] = *(const PG8_LAS bf16x8*)(lds + PG8_SB(b, h) + boff + n * 2048 + k * 1024); } while (0)
#define PG8_MMA(ai, bj, At, Bt) do { __builtin_amdgcn_s_setprio(1); _Pragma("unroll") for (int m = 0; m < 4; ++m) _Pragma("unroll") for (int n = 0; n < 2; ++n) _Pragma("unroll") for (int k = 0; k < 2; ++k) \
        acc[ai][bj][m][n] = __builtin_amdgcn_mfma_f32_16x16x32_bf16(Bt[n][k], At[m][k], acc[ai][bj][m][n], 0, 0, 0); __builtin_amdgcn_s_setprio(0); } while (0)
#define PG8_WAIT_V(n) asm volatile("s_waitcnt vmcnt(" #n ")" ::: "memory")
#define PG8_WAIT_L(n) asm volatile("s_waitcnt lgkmcnt(" #n ")" ::: "memory")
#define PG8_BAR __builtin_amdgcn_s_barrier()
#define PG8_SCHED __builtin_amdgcn_sched_barrier(0)
    Unit cur, nxt; int ui = 0;
    if (!S.next(0, cur)) return;
    f32x4 acc[2][2][4][2];
#pragma unroll
    for (int a = 0; a < 2; ++a)
#pragma unroll
        for (int b = 0; b < 2; ++b)
#pragma unroll
            for (int m = 0; m < 4; ++m)
#pragma unroll
                for (int n = 0; n < 2; ++n) acc[a][b][m][n] = (f32x4){0.f, 0.f, 0.f, 0.f};
    bf16x8 At[4][2], B0[2][2], B1[2][2];
    const char* cA = (const char*)g.A + (size_t)cur.pm * tstep; const char* cB = (const char*)g.Bt + (size_t)cur.pn * tstep;
    S.a_ready(cur);
    if constexpr (SP2) {
        PG8_STAGE(PG8_SB(0, 0), cB, voffB); PG8_STAGE(PG8_SB(0, 1), cB + hstep, voffB); PG8_STAGE(PG8_SA(0, 0), cA, voffA); PG8_STAGE(PG8_SA(0, 1), cA + hstep, voffA);
        if (wr == 1) PG8_BAR;
        PG8_WAIT_V(2); PG8_BAR;
        PG8_STAGE(PG8_SB(1, 0), cB + kstep, voffB); PG8_STAGE(PG8_SA(1, 0), cA + kstep, voffA); PG8_STAGE(PG8_SB(1, 1), cB + hstep + kstep, voffB);
        PG8_WAIT_V(6); PG8_BAR;
    } else {
        PG8_STAGE(PG8_SB(0, 0), cB, voffB); PG8_STAGE(PG8_SA(0, 0), cA, voffA); PG8_STAGE(PG8_SB(0, 1), cB + hstep, voffB); PG8_STAGE(PG8_SA(0, 1), cA + hstep, voffA);
        if (wr == 1) PG8_BAR;
        PG8_WAIT_V(4); PG8_BAR;
        PG8_STAGE(PG8_SB(1, 0), cB + kstep, voffB); PG8_STAGE(PG8_SA(1, 0), cA + kstep, voffA); PG8_STAGE(PG8_SB(1, 1), cB + hstep + kstep, voffB);
        PG8_WAIT_V(6); PG8_BAR;
    }
    for (;;) {
        const bool has_next = S.next(ui + 1, nxt);
        const char* nA = has_next ? (const char*)g.A + (size_t)nxt.pm * tstep : cA; const char* nB = has_next ? (const char*)g.Bt + (size_t)nxt.pn * tstep : cB;
#pragma unroll 1
        for (int t = 0; t < nt; t += 2) {
            const bool last = (t == nt - 2);
            const char* a1 = cA + (size_t)(t + 1) * kstep;
            const char* a2 = last ? nA : cA + (size_t)(t + 2) * kstep; const char* b2 = last ? nB : cB + (size_t)(t + 2) * kstep;
            const char* a3 = a2 + kstep; const char* b3 = b2 + kstep;
            if (last && has_next) S.a_ready(nxt);
            if constexpr (SP2) {
            PG8_LDB(B0, 0, 0); PG8_LDB(B1, 0, 1); PG8_SCHED; PG8_LDA(At, 0, 0); PG8_STAGE(PG8_SA(1, 1), a1 + hstep, voffA);
            PG8_WAIT_V(8); PG8_WAIT_L(0); PG8_BAR; PG8_MMA(0, 0, At, B0); PG8_MMA(0, 1, At, B1); PG8_BAR; PG8_SCHED;
            PG8_LDA(At, 0, 1); PG8_STAGE(PG8_SB(0, 0), b2, voffB); PG8_STAGE(PG8_SB(0, 1), b2 + hstep, voffB); PG8_STAGE(PG8_SA(0, 0), a2, voffA);
            PG8_WAIT_V(8); PG8_WAIT_L(0); PG8_BAR; PG8_MMA(1, 0, At, B0); PG8_MMA(1, 1, At, B1); PG8_BAR; PG8_SCHED;
            PG8_LDB(B0, 1, 0); PG8_LDB(B1, 1, 1); PG8_SCHED; PG8_LDA(At, 1, 0); PG8_STAGE(PG8_SA(0, 1), a2 + hstep, voffA);
            PG8_WAIT_V(8); PG8_WAIT_L(0); PG8_BAR; PG8_MMA(0, 0, At, B0); PG8_MMA(0, 1, At, B1); PG8_BAR; PG8_SCHED;
            PG8_LDA(At, 1, 1); PG8_STAGE(PG8_SB(1, 0), b3, voffB); PG8_STAGE(PG8_SB(1, 1), b3 + hstep, voffB); PG8_STAGE(PG8_SA(1, 0), a3, voffA);
            PG8_WAIT_V(8); PG8_WAIT_L(0); PG8_BAR; PG8_MMA(1, 0, At, B0); PG8_MMA(1, 1, At, B1); PG8_BAR; PG8_SCHED;
            } else {
            PG8_LDB(B0, 0, 0); PG8_SCHED; PG8_LDA(At, 0, 0); PG8_STAGE(PG8_SA(1, 1), a1 + hstep, voffA);
            PG8_WAIT_L(8); PG8_BAR; PG8_WAIT_L(0); PG8_MMA(0, 0, At, B0); PG8_BAR; PG8_SCHED;
            PG8_LDB(B1, 0, 1); PG8_STAGE(PG8_SB(0, 0), b2, voffB);
            PG8_BAR; PG8_WAIT_L(0); PG8_MMA(0, 1, At, B1); PG8_BAR;
            PG8_LDA(At, 0, 1); PG8_STAGE(PG8_SA(0, 0), a2, voffA);
            PG8_BAR; PG8_WAIT_L(0); PG8_MMA(1, 0, At, B0); PG8_BAR; PG8_SCHED;
            PG8_STAGE(PG8_SB(0, 1), b2 + hstep, voffB);
            PG8_WAIT_V(6); PG8_BAR; PG8_MMA(1, 1, At, B1); PG8_BAR;
            PG8_LDB(B0, 1, 0); PG8_SCHED; PG8_LDA(At, 1, 0); PG8_STAGE(PG8_SA(0, 1), a2 + hstep, voffA);
            PG8_WAIT_L(8); PG8_BAR; PG8_WAIT_L(0); PG8_MMA(0, 0, At, B0); PG8_BAR; PG8_SCHED;
            PG8_LDB(B1, 1, 1); PG8_STAGE(PG8_SB(1, 0), b3, voffB);
            PG8_BAR; PG8_WAIT_L(0); PG8_MMA(0, 1, At, B1); PG8_BAR;
            PG8_LDA(At, 1, 1); PG8_STAGE(PG8_SA(1, 0), a3, voffA);
            PG8_BAR; PG8_WAIT_L(0); PG8_MMA(1, 0, At, B0); PG8_BAR; PG8_SCHED;
            PG8_STAGE(PG8_SB(1, 1), b3 + hstep, voffB);
            PG8_WAIT_V(6); PG8_BAR; PG8_MMA(1, 1, At, B1); PG8_BAR;
            }
        }
        if constexpr (ALIGN_EPI) { if (wr == 0) PG8_BAR; }
        if constexpr (!Epi::AFTER_DRAIN) { E(acc, cur, wr, wc, fr, fq); S.done(cur); }
        if (!has_next) break;
#pragma unroll
        for (int a = 0; a < 2; ++a)
#pragma unroll
            for (int b = 0; b < 2; ++b)
#pragma unroll
                for (int m = 0; m < 4; ++m)
#pragma unroll
                    for (int n = 0; n < 2; ++n) acc[a][b][m][n] = (f32x4){0.f, 0.f, 0.f, 0.f};
        cur = nxt; cA = nA; cB = nB; ++ui;
        if constexpr (ALIGN_EPI) { if (wr == 1) PG8_BAR; }
    }
    PG8_WAIT_V(0);
    if constexpr (!ALIGN_EPI) { if (wr == 0) PG8_BAR; }
    PG8_BAR;
    if constexpr (Epi::AFTER_DRAIN) { E.fused(acc, cur, wr, wc, fr, fq, lds, wid, lane); S.done(cur); }
#undef PG8_SA
#undef PG8_SB
#undef PG8_STAGE
#undef PG8_LDA
#undef PG8_LDB
#undef PG8_MMA
#undef PG8_WAIT_V
#undef PG8_WAIT_L
#undef PG8_BAR
#undef PG8_SCHED
}
}

using pg8::bf16_t; using pg8::bf16x8; using pg8::f32x4; using pg8::u32x4;
typedef float f32x2 __attribute__((ext_vector_type(2)));
typedef unsigned u32x2 __attribute__((ext_vector_type(2)));
#define LAS __attribute__((address_space(3)))
constexpr int NWAVES = 8, NTHREADS = 512;
constexpr int T = 32768, D = 1024, L = 8192, NB = 4, FF = 2816, INW = 4864, NH = 12;
constexpr float EPS = 1e-6f;
constexpr int LDS_BYTES = 147456;
constexpr int N_PHASES = 12;

constexpr size_t MiB = 1u << 20, KiB = 1u << 10;
constexpr size_t WS_SS1 = 0, WS_SS2 = 128 * KiB, WS_SS3 = 256 * KiB;
constexpr size_t WS_ABAR = 512 * KiB, WS_A64 = 528 * KiB, WS_BBAR = 576 * KiB;
constexpr size_t WS_LUT = 1088 * KiB;
constexpr size_t WS_WGU1 = 2 * MiB, WS_WD1 = 13 * MiB, WS_WIN = WS_WD1 + 5632 * KiB, WS_WA = WS_WIN + 9728 * KiB, WS_WGLU = WS_WA + 512 * KiB,
                 WS_WS = WS_WGLU + 1 * MiB, WS_WOUT = WS_WS + 1 * MiB, WS_WGU2 = WS_WOUT + 2 * MiB, WS_WD2 = WS_WGU2 + 11 * MiB, WS_WEND = WS_WD2 + 5632 * KiB;
static_assert(WS_WEND <= 50 * MiB, "weights");
constexpr size_t WS_XB = 50 * MiB;
constexpr size_t WS_OC = WS_XB, WS_YG = WS_XB + 16 * MiB;
constexpr size_t WS_RA = 114 * MiB;
constexpr size_t WS_A1 = WS_RA, WS_Q = WS_RA, WS_K = WS_RA + 48 * MiB, WS_VT = WS_RA + 96 * MiB, WS_U = WS_RA + 144 * MiB;
constexpr size_t WS_M1 = WS_RA, WS_YS = WS_RA + 64 * MiB, WS_MG = WS_RA + 96 * MiB;
constexpr size_t WS_G = 290 * MiB;
constexpr size_t WS_OG = 418 * MiB, WS_LSE = 466 * MiB, WS_XC = 468 * MiB, WS_END = 476 * MiB;

struct Params { const float* in[26]; float* out; unsigned char* ws; int ph_lo, ph_hi; unsigned char bk[3][136]; };

__device__ __forceinline__ float wave_sum(float v) {
#pragma unroll
    for (int o = 1; o < 64; o <<= 1) v += __shfl_xor(v, o);
    return v;
}
__device__ __forceinline__ unsigned f2bf(float f) { unsigned u = __builtin_bit_cast(unsigned, f); return (u + 0x7fffu + ((u >> 16) & 1u)) >> 16; }
__device__ __forceinline__ unsigned pk2(float lo, float hi) { return f2bf(lo) | (f2bf(hi) << 16); }
#define LDS_WAIT() asm volatile("s_waitcnt lgkmcnt(0)" ::: "memory")

__device__ __forceinline__ void transpose_item(const float* W, int K, int N, bf16_t* WT, int k0, int n0, int rowbase, const float* gain, LAS float* scr, int lane) {
#pragma unroll 8
    for (int i = 0; i < 32; ++i) { const int kk = 2 * i + (lane >> 5); float v = W[(size_t)(k0 + kk) * N + n0 + (lane & 31)]; if (gain) v *= gain[k0 + kk]; scr[kk * 33 + (lane & 31)] = v; }
    LDS_WAIT();
    const int c = lane & 7;
#pragma unroll
    for (int j = 0; j < 4; ++j) { const int n = (lane >> 3) + 8 * j; const LAS float* s = scr + (8 * c) * 33 + n;
        u32x4 o; o.x = pk2(s[0 * 33], s[1 * 33]); o.y = pk2(s[2 * 33], s[3 * 33]); o.z = pk2(s[4 * 33], s[5 * 33]); o.w = pk2(s[6 * 33], s[7 * 33]);
        *(u32x4*)(WT + (size_t)(rowbase + n) * K + k0 + 8 * c) = o; }
    LDS_WAIT();
}
__device__ __forceinline__ int tdesc_row(int mode, int N, int n0) {
    if (mode == 0) return n0;
    if (mode == 1) return (n0 >> 7) * 256 + (n0 & 127);
    if (mode == 2) return (n0 >> 7) * 256 + 128 + (n0 & 127);
    const int half = N >> 1; const int j = n0 < half ? n0 : n0 - half; return (j >> 7) * 256 + (n0 < half ? 0 : 128) + (j & 127);
}

__device__ __forceinline__ float gelu_tanh(float x) {
    const float u = 0.7978845608028654f * (x + 0.044715f * x * x * x);
    const float e = __expf(2.f * u);
    const float th = 1.f - 2.f * __builtin_amdgcn_rcpf(e + 1.f);
    return 0.5f * x * (1.f + th);
}

__global__ void __launch_bounds__(NTHREADS, 2) fwd_kernel(Params P) {
    extern __shared__ __attribute__((aligned(16))) unsigned char lds_raw[];
    LAS unsigned char* lds = (LAS unsigned char*)lds_raw;
    const int tid = threadIdx.x, lane = tid & 63, wave = __builtin_amdgcn_readfirstlane(tid >> 6);
    const int G = gridDim.x, bid = blockIdx.x;
    const int gw = bid * NWAVES + wave, NGW = G * NWAVES;
    unsigned char* ws = P.ws;
    float* ss1 = (float*)(ws + WS_SS1); float* ss2 = (float*)(ws + WS_SS2); float* ss3 = (float*)(ws + WS_SS3);
    float* abar = (float*)(ws + WS_ABAR); float* a64 = (float*)(ws + WS_A64); float* bbar = (float*)(ws + WS_BBAR); float* lutg = (float*)(ws + WS_LUT);
    bf16_t* Wgu1 = (bf16_t*)(ws + WS_WGU1); bf16_t* Wd1 = (bf16_t*)(ws + WS_WD1); bf16_t* Win = (bf16_t*)(ws + WS_WIN); bf16_t* Wa = (bf16_t*)(ws + WS_WA);
    bf16_t* Wglu = (bf16_t*)(ws + WS_WGLU); bf16_t* Wsb = (bf16_t*)(ws + WS_WS); bf16_t* Wout = (bf16_t*)(ws + WS_WOUT); bf16_t* Wgu2 = (bf16_t*)(ws + WS_WGU2); bf16_t* Wd2 = (bf16_t*)(ws + WS_WD2);
    bf16_t* XB = (bf16_t*)(ws + WS_XB); bf16_t* Oc = (bf16_t*)(ws + WS_OC); bf16_t* Yg = (bf16_t*)(ws + WS_YG);
    bf16_t* A1 = (bf16_t*)(ws + WS_A1); bf16_t* Qp = (bf16_t*)(ws + WS_Q); bf16_t* Kp = (bf16_t*)(ws + WS_K); bf16_t* Vtp = (bf16_t*)(ws + WS_VT); bf16_t* Ub = (bf16_t*)(ws + WS_U);
    bf16_t* M1 = (bf16_t*)(ws + WS_M1); bf16_t* Ys = (bf16_t*)(ws + WS_YS); bf16_t* MG = (bf16_t*)(ws + WS_MG);
    bf16_t* Gt = (bf16_t*)(ws + WS_G); bf16_t* Og = (bf16_t*)(ws + WS_OG); float* LSE = (float*)(ws + WS_LSE); float* Xc = (float*)(ws + WS_XC);
    const float* x = P.in[0];
    float* out = P.out;
    const int lo = P.ph_lo, hi = P.ph_hi;
#ifndef PHMASK
#define PHMASK 0xFFF
#endif
#define IN_PH(k) ((((PHMASK) >> (k)) & 1) && lo <= (k) && (k) < hi)
#define SEAM(k) do { if (IN_PH(k) && IN_PH((k) + 1)) { cg::this_grid().sync(); } } while (0)

    if (IN_PH(0)) {
        LAS float* scr = (LAS float*)(lds + wave * 16384);
        int itbase = 0;
#define DO_MAT(Wp, Kd, Nd, WTp, MODE, GAIN) do { const int nblk = (Nd) / 32, nit = ((Kd) / 64) * nblk; const int first = (gw - (itbase % NGW) + NGW) % NGW; \
            for (int it = first; it < nit; it += NGW) { const int kb = it / nblk, nb = it % nblk; transpose_item((Wp), (Kd), (Nd), (WTp), 64 * kb, 32 * nb, tdesc_row((MODE), (Nd), 32 * nb), (GAIN), scr, lane); } \
            itbase += nit; } while (0)
        DO_MAT(P.in[2], D, FF, Wgu1, 1, (const float*)nullptr); DO_MAT(P.in[3], D, FF, Wgu1, 2, (const float*)nullptr); DO_MAT(P.in[4], FF, D, Wd1, 0, (const float*)nullptr);
        DO_MAT(P.in[6], D, INW, Win, 0, P.in[5]); DO_MAT(P.in[18], 256, D, Wa, 0, (const float*)nullptr); DO_MAT(P.in[17], 512, D, Wglu, 3, (const float*)nullptr);
        DO_MAT(P.in[19], 512, D, Wsb, 0, (const float*)nullptr); DO_MAT(P.in[20], D, D, Wout, 0, (const float*)nullptr);
        DO_MAT(P.in[22], D, FF, Wgu2, 1, P.in[21]); DO_MAT(P.in[23], D, FF, Wgu2, 2, P.in[21]); DO_MAT(P.in[24], FF, D, Wd2, 0, (const float*)nullptr);
#undef DO_MAT
        { const float* g1 = P.in[1];
          for (int r = gw; r < T; r += NGW) {
            const f32x4* xr = (const f32x4*)(x + (size_t)r * D) + lane; f32x4 v[4]; float s = 0.f;
#pragma unroll
            for (int j = 0; j < 4; ++j) { v[j] = xr[64 * j]; s += (v[j][0] * v[j][0] + v[j][1] * v[j][1]) + (v[j][2] * v[j][2] + v[j][3] * v[j][3]); }
            const float rinv = 1.0f / sqrtf(wave_sum(s) * (1.0f / D) + EPS);
            u32x2* o8 = (u32x2*)(XB + (size_t)r * D) + lane;
#pragma unroll
            for (int j = 0; j < 4; ++j) { const f32x4 gg = ((const f32x4*)g1)[lane + 64 * j]; u32x2 w; w.x = pk2(v[j][0] * rinv * gg[0], v[j][1] * rinv * gg[1]); w.y = pk2(v[j][2] * rinv * gg[2], v[j][3] * rinv * gg[3]); o8[64 * j] = w; }
          } }
        for (int i = bid * NTHREADS + tid; i < 3 * T; i += G * NTHREADS) ((float*)(ws + WS_SS1))[i] = 0.f;
        for (int i = bid * NTHREADS + tid; i < 32 * 64; i += G * NTHREADS) {
            const int g = i >> 6;
            const float dt = expf(P.in[11][g]), lre = P.in[9][i], lim = P.in[10][i];
            const float zr = lre * dt, zi = lim * dt, em1 = expm1f(zr), mag = em1 + 1.0f, cz = cosf(zi), sz = sinf(zi), sh = sinf(0.5f * zi);
            const float abre = mag * cz, abim = mag * sz;
            const float xr = em1 * cz - 2.0f * sh * sh;
            const float den = lre * lre + lim * lim;
            const float cre = (xr * lre + abim * lim) / den, cim = (abim * lre - xr * lim) / den;
            abar[2 * i] = abre; abar[2 * i + 1] = abim;
            float pr = abre, pi = abim;
#pragma unroll
            for (int k = 0; k < 6; ++k) { const float nr = pr * pr - pi * pi, ni = 2.f * pr * pi; pr = nr; pi = ni; }
            a64[2 * i] = pr; a64[2 * i + 1] = pi;
            for (int c = 0; c < 16; ++c) { const float br = P.in[12][i * 16 + c], bi = P.in[13][i * 16 + c];
                bbar[i * 32 + c] = cre * br - cim * bi; bbar[i * 32 + 16 + c] = cre * bi + cim * br; }
        }
        for (int i = bid * NTHREADS + tid; i < 12 * 132; i += G * NTHREADS) { const int h = i / 132, s = i % 132; lutg[i] = (s <= 128) ? P.in[8][(int)P.bk[h >> 2][s] * 12 + h] : 0.f; }
    }
    SEAM(0);

    if (IN_PH(1)) {
        pg8::Gemm g{XB, Wgu1, T, 2 * FF, D}; pg8::StaticOrder S; S.init(T, 2 * FF, G, bid);
        pg8::EpiSwiglu E{A1, FF, nullptr};
        pg8::gemm_phase<pg8::EpiSwiglu, pg8::StaticOrder, true, true>(lds, g, S, E);
    }
    SEAM(1);
    if (IN_PH(2)) {
        pg8::Gemm g{A1, Wd1, T, D, FF}; pg8::StaticOrder S; S.init(T, D, G, bid);
        pg8::EpiResid E{x, out, XB, ss1, 0.5f};
        pg8::gemm_phase<pg8::EpiResid, pg8::StaticOrder, true, true>(lds, g, S, E);
    }
    SEAM(2);
    if (IN_PH(3)) {
        pg8::Gemm g{XB, Win, T, INW, D}; pg8::StaticOrder S; S.init(T, INW, G, bid);
        pg8::EpiZ E{Qp, Kp, Vtp, Ub, Gt, ss1, P.in[7]};
        pg8::gemm_phase<pg8::EpiZ, pg8::StaticOrder, true, true>(lds, g, S, E);
    }
    SEAM(3);
    if (IN_PH(4)) {
        LAS float* lut = (LAS float*)lds;
        for (int i = tid; i < 12 * 132; i += NTHREADS) lut[i] = lutg[i];
        __syncthreads();
        const int fr = lane & 15, fq = lane >> 4;
        for (int bu = bid; bu < NB * NH * 64; bu += G) {
            const int bh = bu >> 6, blk = bu & 63, b = bh / NH, h = bh - b * NH, g = h >> 2, sh = 2 * g, lm = 13 - sh, Msub = 1 << lm;
            const int tq0 = blk * 128 + 16 * wave, r = tq0 >> lm, m0 = tq0 & (Msub - 1);
            const bf16_t* Qb = Qp + (size_t)bh * L * 64; const bf16_t* Kb = Kp + (size_t)bh * L * 64; const bf16_t* Vb = Vtp + (size_t)bh * 64 * L;
            const LAS float* luth = lut + h * 132;
            bf16x8 qf[2];
#pragma unroll
            for (int ks = 0; ks < 2; ++ks) qf[ks] = *(const bf16x8*)(Qb + (size_t)(tq0 + fr) * 64 + 32 * ks + 8 * fq);
            float s[9][4];
#pragma unroll
            for (int kt = 1; kt <= 9; ++kt) {
                const int kb = m0 - 144 + 16 * kt;
                if (kb >= 0) {
                    const bf16_t* kp = Kb + (size_t)((r << lm) + kb + fr) * 64 + 8 * fq;
                    const bf16x8 k0 = *(const bf16x8*)kp, k1 = *(const bf16x8*)(kp + 32);
                    f32x4 a = (f32x4){0.f, 0.f, 0.f, 0.f};
                    a = __builtin_amdgcn_mfma_f32_16x16x32_bf16(k0, qf[0], a, 0, 0, 0);
                    a = __builtin_amdgcn_mfma_f32_16x16x32_bf16(k1, qf[1], a, 0, 0, 0);
#pragma unroll
                    for (int i = 0; i < 4; ++i) { const int st = (m0 + fr) - (kb + 4 * fq + i); const bool ok = (st >= 0) && (st <= 128);
                        const int sc = st < 0 ? 0 : (st > 128 ? 128 : st); s[kt - 1][i] = ok ? a[i] + luth[sc] : -1e30f; }
                } else {
#pragma unroll
                    for (int i = 0; i < 4; ++i) s[kt - 1][i] = -1e30f;
                }
            }
            float mx = -1e30f;
#pragma unroll
            for (int kt = 0; kt < 9; ++kt)
#pragma unroll
                for (int i = 0; i < 4; ++i) mx = fmaxf(mx, s[kt][i]);
            mx = fmaxf(mx, __shfl_xor(mx, 16)); mx = fmaxf(mx, __shfl_xor(mx, 32));
            float lsum = 0.f;
#pragma unroll
            for (int kt = 0; kt < 9; ++kt)
#pragma unroll
                for (int i = 0; i < 4; ++i) { s[kt][i] = __expf(s[kt][i] - mx); lsum += s[kt][i]; }
            lsum += __shfl_xor(lsum, 16); lsum += __shfl_xor(lsum, 32);
            f32x4 oacc[4];
#pragma unroll
            for (int dt = 0; dt < 4; ++dt) oacc[dt] = (f32x4){0.f, 0.f, 0.f, 0.f};
#pragma unroll
            for (int kp = 0; kp < 5; ++kp) {
                const int kb0 = m0 - 144 + 32 * kp, kb1 = kb0 + 16;
                u32x4 pw;
                if (kp == 0) { pw.x = 0u; pw.y = 0u; } else { pw.x = pg8::cvt_pk_bf16(s[2 * kp - 1][0], s[2 * kp - 1][1]); pw.y = pg8::cvt_pk_bf16(s[2 * kp - 1][2], s[2 * kp - 1][3]); }
                pw.z = pg8::cvt_pk_bf16(s[2 * kp][0], s[2 * kp][1]); pw.w = pg8::cvt_pk_bf16(s[2 * kp][2], s[2 * kp][3]);
                const bf16x8 pf = __builtin_bit_cast(bf16x8, pw);
                if (kb1 >= 0) {
#pragma unroll
                    for (int dt = 0; dt < 4; ++dt) {
                        const bf16_t* vp = Vb + (size_t)(16 * dt + fr) * L + (r << lm) + kb0 + 4 * fq;
                        u32x2 lo2 = (u32x2){0u, 0u};
                        if (kp > 0 && kb0 >= 0) lo2 = *(const u32x2*)vp;
                        const u32x2 hi2 = *(const u32x2*)(vp + 16);
                        const u32x4 vw = (u32x4){lo2.x, lo2.y, hi2.x, hi2.y};
                        oacc[dt] = __builtin_amdgcn_mfma_f32_16x16x32_bf16(__builtin_bit_cast(bf16x8, vw), pf, oacc[dt], 0, 0, 0);
                    }
                }
            }
            const float inv = 1.0f / lsum;
            const int tok = b * L + ((m0 + fr) << sh) + r;
            bf16_t* op = Og + ((size_t)g * T + tok) * 256 + (h & 3) * 64 + 4 * fq;
#pragma unroll
            for (int dt = 0; dt < 4; ++dt) { u32x2 w; w.x = pg8::cvt_pk_bf16(oacc[dt][0] * inv, oacc[dt][1] * inv); w.y = pg8::cvt_pk_bf16(oacc[dt][2] * inv, oacc[dt][3] * inv); *(u32x2*)(op + 16 * dt) = w; }
            if (fq == 0) LSE[((size_t)g * T + tok) * 4 + (h & 3)] = mx + __logf(lsum);
        }
        __syncthreads();
        {
            LAS float* ub = (LAS float*)(lds + 8192 + wave * 4096);
            for (int su = gw; su < NB * 32 * 128; su += NGW) {
                const int c = su & 127, g = (su >> 7) & 31, b = su >> 12;
                const int gi = g * 64 + lane;
                const float are = abar[2 * gi], aim = abar[2 * gi + 1];
                float bre[16], bim[16];
#pragma unroll
                for (int k = 0; k < 16; ++k) { bre[k] = bbar[gi * 32 + k]; bim[k] = bbar[gi * 32 + 16 + k]; }
                { const bf16_t* up = Ub + (size_t)(b * L + c * 64 + lane) * 512 + 16 * g; const u32x4 w0 = *(const u32x4*)up, w1 = *(const u32x4*)(up + 8);
                  f32x4 a0, a1, a2, a3; pg8::unpack8(w0, a0, a1); pg8::unpack8(w1, a2, a3);
                  LAS f32x4* d4 = (LAS f32x4*)(ub + lane * 16); d4[0] = a0; d4[1] = a1; d4[2] = a2; d4[3] = a3; }
                LDS_WAIT();
                float sre = 0.f, sim = 0.f;
#pragma unroll 4
                for (int t = 0; t < 64; ++t) {
                    const LAS f32x4* u4 = (const LAS f32x4*)(ub + t * 16);
                    float bur = 0.f, bui = 0.f;
#pragma unroll
                    for (int q = 0; q < 4; ++q) { const f32x4 uu = u4[q];
#pragma unroll
                        for (int e = 0; e < 4; ++e) { bur += bre[4 * q + e] * uu[e]; bui += bim[4 * q + e] * uu[e]; } }
                    const float nr = are * sre - aim * sim + bur, ni = are * sim + aim * sre + bui; sre = nr; sim = ni;
                }
                *(f32x2*)(Xc + ((size_t)((b * 32 + g) * 128 + c) * 64 + lane) * 2) = (f32x2){sre, sim};
                LDS_WAIT();
            }
        }
    }
    SEAM(4);
    if (IN_PH(5)) {
        LAS float* cbuf = (LAS float*)lds;
        LAS float* ub = (LAS float*)(lds + 8192 + wave * 12352);
        LAS float* sb = ub + 1024;
        const float* cre_g = P.in[14]; const float* cim_g = P.in[15]; const float* dsk = P.in[16];
        for (int bu = bid; bu < NB * 32 * 16; bu += G) {
            const int b = bu >> 9, g = (bu >> 4) & 31, c = (bu & 15) * 8 + wave;
            __syncthreads();
            for (int idx = tid; idx < 1024; idx += NTHREADS) { const int cc = idx >> 6, n = idx & 63;
                cbuf[(n * 4 + (cc >> 2)) * 8 + (cc & 3)] = cre_g[(g * 16 + cc) * 64 + n]; cbuf[(n * 4 + (cc >> 2)) * 8 + 4 + (cc & 3)] = cim_g[(g * 16 + cc) * 64 + n]; }
            __syncthreads();
            const int gi = g * 64 + lane;
            const float are = abar[2 * gi], aim = abar[2 * gi + 1], a6r = a64[2 * gi], a6i = a64[2 * gi + 1];
            float bre[16], bim[16];
#pragma unroll
            for (int k = 0; k < 16; ++k) { bre[k] = bbar[gi * 32 + k]; bim[k] = bbar[gi * 32 + 16 + k]; }
            float sre = 0.f, sim = 0.f;
            { const f32x2* xp = (const f32x2*)(Xc + ((size_t)(b * 32 + g) * 128 * 64 + lane) * 2);
              for (int j = 0; j < c; ++j) { const f32x2 xv = xp[(size_t)j * 64]; const float nr = a6r * sre - a6i * sim + xv[0], ni = a6r * sim + a6i * sre + xv[1]; sre = nr; sim = ni; } }
            { const bf16_t* up = Ub + (size_t)(b * L + c * 64 + lane) * 512 + 16 * g; const u32x4 w0 = *(const u32x4*)up, w1 = *(const u32x4*)(up + 8);
              f32x4 a0, a1, a2, a3; pg8::unpack8(w0, a0, a1); pg8::unpack8(w1, a2, a3);
              LAS f32x4* d4 = (LAS f32x4*)(ub + lane * 16); d4[0] = a0; d4[1] = a1; d4[2] = a2; d4[3] = a3; }
            LDS_WAIT();
            const int ty = lane & 15, cq = lane >> 4;
            const f32x4 dk = *(const f32x4*)(dsk + 16 * g + 4 * cq);
#pragma unroll 1
            for (int sub = 0; sub < 4; ++sub) {
#pragma unroll 4
                for (int tt = 0; tt < 16; ++tt) {
                    const LAS f32x4* u4 = (const LAS f32x4*)(ub + (sub * 16 + tt) * 16);
                    float bur = 0.f, bui = 0.f;
#pragma unroll
                    for (int q = 0; q < 4; ++q) { const f32x4 uu = u4[q];
#pragma unroll
                        for (int e = 0; e < 4; ++e) { bur += bre[4 * q + e] * uu[e]; bui += bim[4 * q + e] * uu[e]; } }
                    const float nr = are * sre - aim * sim + bur, ni = are * sim + aim * sre + bui; sre = nr; sim = ni;
                    sb[tt * 129 + lane] = sre; sb[tt * 129 + 64 + lane] = sim;
                }
                LDS_WAIT();
                f32x4 y = (f32x4){0.f, 0.f, 0.f, 0.f};
#pragma unroll 8
                for (int n = 0; n < 64; ++n) {
                    const float vr = sb[ty * 129 + n], vi = sb[ty * 129 + 64 + n];
                    const LAS f32x4* c4 = (const LAS f32x4*)(cbuf + (n * 4 + cq) * 8);
                    y += c4[0] * vr - c4[1] * vi;
                }
                const f32x4 uu = *(const LAS f32x4*)(ub + (sub * 16 + ty) * 16 + 4 * cq);
                y += dk * uu;
                u32x2 w; w.x = pg8::cvt_pk_bf16(gelu_tanh(y[0]), gelu_tanh(y[1])); w.y = pg8::cvt_pk_bf16(gelu_tanh(y[2]), gelu_tanh(y[3]));
                *(u32x2*)(Yg + (size_t)(b * L + c * 64 + sub * 16 + ty) * 512 + 16 * g + 4 * cq) = w;
                LDS_WAIT();
            }
        }
        for (int i = bid * NTHREADS + tid; i < T * 32; i += G * NTHREADS) {
            const int tok = i >> 5, ch = i & 31, j = ch >> 3;
            const float l0 = LSE[((size_t)0 * T + tok) * 4 + j], l1 = LSE[((size_t)1 * T + tok) * 4 + j], l2 = LSE[((size_t)2 * T + tok) * 4 + j];
            const float mx = fmaxf(l0, fmaxf(l1, l2)); const float e0 = __expf(l0 - mx), e1 = __expf(l1 - mx), e2 = __expf(l2 - mx); const float inv = 1.0f / (e0 + e1 + e2);
            f32x4 a0, a1, b0, b1, c0, c1;
            pg8::unpack8(*(const u32x4*)(Og + ((size_t)0 * T + tok) * 256 + 8 * ch), a0, a1);
            pg8::unpack8(*(const u32x4*)(Og + ((size_t)1 * T + tok) * 256 + 8 * ch), b0, b1);
            pg8::unpack8(*(const u32x4*)(Og + ((size_t)2 * T + tok) * 256 + 8 * ch), c0, c1);
            const float w0 = e0 * inv, w1 = e1 * inv, w2 = e2 * inv;
            *(u32x4*)(Oc + (size_t)tok * 256 + 8 * ch) = pg8::pack8(a0 * w0 + b0 * w1 + c0 * w2, a1 * w0 + b1 * w1 + c1 * w2);
        }
        __syncthreads();
    }
    SEAM(5);
    if (IN_PH(6)) {
#ifndef P6SEL
#define P6SEL 3
#endif
        if (P6SEL & 1) { pg8::Gemm g{Oc, Wa, T, D, 256}; pg8::StaticOrder S; S.init(T, D, G, bid);
          pg8::EpiGateMul E{M1, Gt};
          pg8::gemm_phase<pg8::EpiGateMul, pg8::StaticOrder, true, true>(lds, g, S, E); }
        if (P6SEL & 2) { pg8::Gemm g{Yg, Wglu, T, D, 512}; pg8::StaticOrder S; S.init(T, D, G, bid);
          pg8::EpiGlu E{Ys};
          pg8::gemm_phase<pg8::EpiGlu, pg8::StaticOrder, true, true>(lds, g, S, E); }
    }
    SEAM(6);
    if (IN_PH(7)) {
        pg8::Gemm g{Ys, Wsb, T, D, 512}; pg8::StaticOrder S; S.init(T, D, G, bid);
        pg8::EpiMerge E{MG, M1, Gt + 1024};
        pg8::gemm_phase<pg8::EpiMerge, pg8::StaticOrder, true, true>(lds, g, S, E);
    }
    SEAM(7);
    if (IN_PH(8)) {
        pg8::Gemm g{MG, Wout, T, D, D}; pg8::StaticOrder S; S.init(T, D, G, bid);
        pg8::EpiResid E{out, out, XB, ss2, 1.0f};
        pg8::gemm_phase<pg8::EpiResid, pg8::StaticOrder, true, true>(lds, g, S, E);
    }
    SEAM(8);
    if (IN_PH(9)) {
        pg8::Gemm g{XB, Wgu2, T, 2 * FF, D}; pg8::StaticOrder S; S.init(T, 2 * FF, G, bid);
        pg8::EpiSwiglu E{A1, FF, ss2};
        pg8::gemm_phase<pg8::EpiSwiglu, pg8::StaticOrder, true, true>(lds, g, S, E);
    }
    SEAM(9);
    if (IN_PH(10)) {
        pg8::Gemm g{A1, Wd2, T, D, FF}; pg8::StaticOrder S; S.init(T, D, G, bid);
        pg8::EpiResid E{out, out, nullptr, ss3, 0.5f};
        pg8::gemm_phase<pg8::EpiResid, pg8::StaticOrder, true, true>(lds, g, S, E);
    }
    SEAM(10);
    if (IN_PH(11)) {
        const float* gf = P.in[25];
        for (int r = gw; r < T; r += NGW) {
            const float rinv = 1.0f / sqrtf(ss3[r] * (1.0f / D) + EPS);
            f32x4* xr = (f32x4*)(out + (size_t)r * D) + lane;
#pragma unroll
            for (int j = 0; j < 4; ++j) { const f32x4 gg = ((const f32x4*)gf)[lane + 64 * j]; xr[64 * j] = xr[64 * j] * rinv * gg; }
        }
    }
#undef IN_PH
#undef SEAM
}

extern "C" void kernel_launch(void* const* d_in, const int* in_sizes, int n_in, void* d_out, int out_size, void* d_ws, size_t ws_size, hipStream_t stream) {
    static int grid = 0;
    if (grid == 0) {
        if (n_in != 26 || ws_size < WS_END) { fprintf(stderr, "kernel_launch: expected 26 inputs and >= %zu bytes of workspace; got %d, %zu\n", (size_t)WS_END, n_in, ws_size); grid = -1; return; }
        int dev = 0, cus = 0, per_cu = 0;
        hipGetDevice(&dev); hipDeviceGetAttribute(&cus, hipDeviceAttributeMultiprocessorCount, dev);
        if (hipFuncSetAttribute((const void*)fwd_kernel, hipFuncAttributeMaxDynamicSharedMemorySize, LDS_BYTES) != hipSuccess) { fprintf(stderr, "kernel_launch: hipFuncSetAttribute failed\n"); grid = -1; return; }
        hipOccupancyMaxActiveBlocksPerMultiprocessor(&per_cu, (const void*)fwd_kernel, NTHREADS, LDS_BYTES);
        if (per_cu < 1) { fprintf(stderr, "kernel_launch: occupancy query says %d blocks per CU\n", per_cu); per_cu = 1; }
        (void)hipGetLastError();
        grid = cus;
        fprintf(stderr, "kernel_launch: grid %d (CUs %d, occupancy %d per CU)\n", grid, cus, per_cu);
    }
    if (grid < 0) return;
    Params p{};
    for (int i = 0; i < 26; ++i) p.in[i] = (const float*)d_in[i];
    p.out = (float*)d_out; p.ws = (unsigned char*)d_ws;
    for (int g = 0; g < 3; ++g) { const int dil = g == 0 ? 1 : (g == 1 ? 4 : 16);
        for (int s = 0; s <= 128; ++s) { const int dist = s * dil; int bkt;
            if (dist < 16) bkt = dist; else { const float dd = (float)dist; int large = 16 + (int)(logf(dd / 16.0f) / (float)log(128.0) * 16.0f); if (large > 31) large = 31; bkt = large; }
            p.bk[g][s] = (unsigned char)bkt; } }
#if ONE_LAUNCH
    p.ph_lo = 0; p.ph_hi = N_PHASES;
    void* args[] = {&p};
    hipError_t e = hipLaunchCooperativeKernel((const void*)fwd_kernel, dim3(grid), dim3(NTHREADS), args, LDS_BYTES, stream);
    if (e != hipSuccess) fprintf(stderr, "cooperative launch failed: %s (grid %d)\n", hipGetErrorString(e), grid);
#else
    for (int ph = 0; ph < N_PHASES; ++ph) { p.ph_lo = ph; p.ph_hi = ph + 1; hipLaunchKernelGGL(fwd_kernel, dim3(grid), dim3(NTHREADS), LDS_BYTES, stream, p); }
#endif
}
```

```cpp
#include <hip/hip_runtime.h>
#include <hip/hip_cooperative_groups.h>
#include <cstdio>
#include <cstdint>
#include <cmath>
namespace cg = cooperative_groups;
#ifndef ONE_LAUNCH
#define ONE_LAUNCH 1
#endif
namespace pg8 {
#define PG8_LAS __attribute__((address_space(3)))
typedef unsigned short bf16_t;
typedef short bf16x8 __attribute__((ext_vector_type(8)));
typedef float f32x4 __attribute__((ext_vector_type(4)));
typedef unsigned u32x4 __attribute__((ext_vector_type(4)));
constexpr int BM = 256, BK = 64, HALF = 128, HTB = HALF * BK * 2  , STAGE_BYTES = 8 * HTB, NXCD = 8, WGM = 8;

__host__ __device__ __forceinline__ int lds_byte(int r, int c) { const int st = (r >> 4) * 2 + (c >> 5), rr = r & 15, cc = c & 31, ob = rr * 64 + cc * 2; return st * 1024 + (ob ^ (((ob >> 9) & 1) << 5)); }
__host__ __device__ __forceinline__ void stage_rc(int b, int& R, int& C) { const int st = b / 1024, sb = b % 1024, swz = sb ^ (((sb >> 9) & 1) << 5); R = (st >> 1) * 16 + swz / 64; C = (st & 1) * 32 + (swz % 64) / 2; }
__host__ __device__ __forceinline__ int perm32(int rho) { const int n = rho >> 4, i = rho & 15; return 8 * (i >> 2) + 4 * n + (i & 3); }

struct Unit { int pm, pn; };
struct Gemm { const bf16_t* A; const bf16_t* Bt; int M, N, K, lda, ldb, mtpg; size_t bgs; };

struct StaticOrder {
    int nM, nN, nwg, G, c;
    __host__ __device__ void init(int M, int N, int G_, int c_) { nM = M / BM; nN = N / BM; nwg = nM * nN; G = G_; c = c_; }
    __host__ __device__ bool next(int i, Unit& u) const {
        const long L = (long)i * G + c; if (L >= nwg) return false;
        int wgid = (int)L; { const int q = nwg / NXCD, r = nwg % NXCD, xcd = wgid % NXCD, off = wgid / NXCD; wgid = (xcd < r ? xcd * (q + 1) : r * (q + 1) + (xcd - r) * q) + off; }
        const int nig = WGM * nN, gid = wgid / nig, fm = gid * WGM, gsz = (nM - fm) < WGM ? (nM - fm) : WGM;
        u.pm = fm + ((wgid % nig) % gsz); u.pn = (wgid % nig) / gsz; return true;
    }
    __device__ __forceinline__ void a_ready(const Unit&) const {}
    __device__ __forceinline__ void done(const Unit&) const {}
};


constexpr float RMS_EPS = 1e-6f;
constexpr int TOK = 32768, DM = 1024, SEQL = 8192;
typedef float f32x2_t __attribute__((ext_vector_type(2))); typedef __bf16 bf16x2_t __attribute__((ext_vector_type(2)));
__device__ __forceinline__ unsigned cvt_pk_bf16(float lo, float hi) { const f32x2_t v = {lo, hi}; const bf16x2_t b = __builtin_convertvector(v, bf16x2_t); return __builtin_bit_cast(unsigned, b); }
__device__ __forceinline__ u32x4 pack8(const f32x4& a, const f32x4& b) { u32x4 w; w.x = cvt_pk_bf16(a[0], a[1]); w.y = cvt_pk_bf16(a[2], a[3]); w.z = cvt_pk_bf16(b[0], b[1]); w.w = cvt_pk_bf16(b[2], b[3]); return w; }
__device__ __forceinline__ float bf_lo(unsigned w) { return __uint_as_float(w << 16); }
__device__ __forceinline__ float bf_hi(unsigned w) { return __uint_as_float(w & 0xffff0000u); }
__device__ __forceinline__ void unpack8(const u32x4& w, f32x4& a, f32x4& b) { a = (f32x4){bf_lo(w.x), bf_hi(w.x), bf_lo(w.y), bf_hi(w.y)}; b = (f32x4){bf_lo(w.z), bf_hi(w.z), bf_lo(w.w), bf_hi(w.w)}; }
__device__ __forceinline__ float sigm(float x) { return __builtin_amdgcn_rcpf(1.f + __expf(-x)); }
__device__ __forceinline__ f32x4 sigm4(const f32x4& x) { return (f32x4){sigm(x[0]), sigm(x[1]), sigm(x[2]), sigm(x[3])}; }
__device__ __forceinline__ float row_rs(const float* ss, int row) { return ss ? __builtin_amdgcn_rsqf(ss[row] * (1.0f / 1024.0f) + RMS_EPS) : 1.0f; }

struct EpiSwiglu {
    static constexpr bool PERM = true, AFTER_DRAIN = false;
    bf16_t* O; int ldo; const float* ss;
    __device__ __forceinline__ void operator()(const f32x4 (&acc)[2][2][4][2], const Unit& u, int wr, int wc, int fr, int fq) const {
        const int col0 = u.pn * 128 + wc * 32 + 8 * fq;
#pragma unroll
        for (int ai = 0; ai < 2; ++ai)
#pragma unroll
            for (int m = 0; m < 4; ++m) {
                const int row = u.pm * BM + ai * HALF + wr * 64 + m * 16 + fr; const float rs = row_rs(ss, row);
                f32x4 o[2];
#pragma unroll
                for (int n = 0; n < 2; ++n) { const f32x4 g = acc[ai][0][m][n] * rs, up = acc[ai][1][m][n] * rs; o[n] = g * sigm4(g) * up; }
                *(u32x4*)(O + (size_t)row * ldo + col0) = pack8(o[0], o[1]);
            }
    }
};
struct EpiResid {
    static constexpr bool PERM = true, AFTER_DRAIN = false;
    const float* base; float* out; bf16_t* xb; float* ss; float alpha;
    __device__ __forceinline__ void operator()(const f32x4 (&acc)[2][2][4][2], const Unit& u, int wr, int wc, int fr, int fq) const {
        const int col0 = u.pn * BM + wc * 32 + 8 * fq;
#pragma unroll
        for (int ai = 0; ai < 2; ++ai)
#pragma unroll
            for (int m = 0; m < 4; ++m) {
                const int row = u.pm * BM + ai * HALF + wr * 64 + m * 16 + fr; float sq = 0.f;
#pragma unroll
                for (int bj = 0; bj < 2; ++bj) {
                    const size_t off = (size_t)row * DM + col0 + bj * HALF;
                    const f32x4 b0 = *(const f32x4*)(base + off), b1 = *(const f32x4*)(base + off + 4);
                    const f32x4 x0 = b0 + acc[ai][bj][m][0] * alpha, x1 = b1 + acc[ai][bj][m][1] * alpha;
                    *(f32x4*)(out + off) = x0; *(f32x4*)(out + off + 4) = x1;
                    if (xb) *(u32x4*)(xb + off) = pack8(x0, x1);
                    sq += (x0[0] * x0[0] + x0[1] * x0[1]) + (x0[2] * x0[2] + x0[3] * x0[3]) + (x1[0] * x1[0] + x1[1] * x1[1]) + (x1[2] * x1[2] + x1[3] * x1[3]);
                }
                if (ss) { sq += __shfl_xor(sq, 16); sq += __shfl_xor(sq, 32); if (fq == 0) unsafeAtomicAdd(ss + row, sq); }
                asm volatile("" ::: "memory");
            }
    }
};
struct EpiZ {
    static constexpr bool PERM = true, AFTER_DRAIN = false;
    bf16_t *Q, *K, *Vt, *U, *G; const float* ss; const float* gbias;
    __device__ __forceinline__ void operator()(const f32x4 (&acc)[2][2][4][2], const Unit& u, int wr, int wc, int fr, int fq) const {
        const int pn = u.pn;
#pragma unroll
        for (int ai = 0; ai < 2; ++ai)
#pragma unroll
            for (int m = 0; m < 4; ++m) {
                const int row = u.pm * BM + ai * HALF + wr * 64 + m * 16 + fr; const float rs = row_rs(ss, row);
                const int b = row >> 13, tt = row & (SEQL - 1);
#pragma unroll
                for (int bj = 0; bj < 2; ++bj) {
                    f32x4 z0 = acc[ai][bj][m][0] * rs, z1 = acc[ai][bj][m][1] * rs;
                    const int ct = bj * HALF + wc * 32 + 8 * fq;
                    if (pn < 9) {
                        const int seg = pn / 3, cs = (pn - seg * 3) * BM + ct, h = cs >> 6, dd0 = cs & 63, sh = 2 * (h >> 2);
                        const int tp = ((tt & ((1 << sh) - 1)) << (13 - sh)) + (tt >> sh);
                        const size_t bh = (size_t)(b * 12 + h);
                        if (seg == 0) { z0 = z0 * 0.125f; z1 = z1 * 0.125f; *(u32x4*)(Q + (bh * SEQL + tp) * 64 + dd0) = pack8(z0, z1); }
                        else if (seg == 1) { *(u32x4*)(K + (bh * SEQL + tp) * 64 + dd0) = pack8(z0, z1); }
                        else { const u32x4 w = pack8(z0, z1); bf16_t* vp = Vt + (bh * 64 + dd0) * SEQL + tp;
                            vp[0 * SEQL] = (bf16_t)(w.x & 0xffffu); vp[1 * SEQL] = (bf16_t)(w.x >> 16); vp[2 * SEQL] = (bf16_t)(w.y & 0xffffu); vp[3 * SEQL] = (bf16_t)(w.y >> 16);
                            vp[4 * SEQL] = (bf16_t)(w.z & 0xffffu); vp[5 * SEQL] = (bf16_t)(w.z >> 16); vp[6 * SEQL] = (bf16_t)(w.w & 0xffffu); vp[7 * SEQL] = (bf16_t)(w.w >> 16); }
                    } else if (pn < 11) {
                        const int cu = (pn - 9) * BM + ct, gg = cu >> 4;
                        *(u32x4*)(U + ((size_t)(gg * 1024 + b * 256 + (tt >> 5)) * 640 + (tt & 31) * 16 + (cu & 15))) = pack8(z0, z1);
                    } else {
                        const int cg_ = (pn - 11) * BM + ct;
                        const f32x4 g0 = *(const f32x4*)(gbias + cg_), g1 = *(const f32x4*)(gbias + cg_ + 4);
                        z0 = sigm4(z0 + g0); z1 = sigm4(z1 + g1);
                        *(u32x4*)(G + (size_t)row * 2048 + cg_) = pack8(z0, z1);
                    }
                }
            }
    }
};
struct EpiGateMul {
    static constexpr bool PERM = true, AFTER_DRAIN = false;
    bf16_t* O; const bf16_t* Gt;
    __device__ __forceinline__ void operator()(const f32x4 (&acc)[2][2][4][2], const Unit& u, int wr, int wc, int fr, int fq) const {
        const int col0 = u.pn * BM + wc * 32 + 8 * fq;
#pragma unroll
        for (int ai = 0; ai < 2; ++ai)
#pragma unroll
            for (int m = 0; m < 4; ++m) {
                const int row = u.pm * BM + ai * HALF + wr * 64 + m * 16 + fr;
#pragma unroll
                for (int bj = 0; bj < 2; ++bj) {
                    const int c = col0 + bj * HALF; f32x4 g0, g1; unpack8(*(const u32x4*)(Gt + (size_t)row * 2048 + c), g0, g1);
                    *(u32x4*)(O + (size_t)row * DM + c) = pack8(acc[ai][bj][m][0] * g0, acc[ai][bj][m][1] * g1);
                }
                asm volatile("" ::: "memory");
            }
    }
};
struct EpiGlu {
    static constexpr bool PERM = true, AFTER_DRAIN = false;
    bf16_t* O;
    __device__ __forceinline__ void operator()(const f32x4 (&acc)[2][2][4][2], const Unit& u, int wr, int wc, int fr, int fq) const {
        const int col0 = u.pn * 128 + wc * 32 + 8 * fq;
#pragma unroll
        for (int ai = 0; ai < 2; ++ai)
#pragma unroll
            for (int m = 0; m < 4; ++m) {
                const int row = u.pm * BM + ai * HALF + wr * 64 + m * 16 + fr;
                *(u32x4*)(O + (size_t)row * 512 + col0) = pack8(acc[ai][0][m][0] * sigm4(acc[ai][1][m][0]), acc[ai][0][m][1] * sigm4(acc[ai][1][m][1]));
            }
    }
};
struct EpiMerge {
    static constexpr bool PERM = true, AFTER_DRAIN = false;
    bf16_t* O; const bf16_t* M1; const bf16_t* Gt;
    __device__ __forceinline__ void operator()(const f32x4 (&acc)[2][2][4][2], const Unit& u, int wr, int wc, int fr, int fq) const {
        const int col0 = u.pn * BM + wc * 32 + 8 * fq;
#pragma unroll
        for (int ai = 0; ai < 2; ++ai)
#pragma unroll
            for (int m = 0; m < 4; ++m) {
                const int row = u.pm * BM + ai * HALF + wr * 64 + m * 16 + fr;
#pragma unroll
                for (int bj = 0; bj < 2; ++bj) {
                    const int c = col0 + bj * HALF; f32x4 g0, g1, a0, a1;
                    unpack8(*(const u32x4*)(Gt + (size_t)row * 2048 + c), g0, g1); unpack8(*(const u32x4*)(M1 + (size_t)row * DM + c), a0, a1);
                    *(u32x4*)(O + (size_t)row * DM + c) = pack8(a0 + acc[ai][bj][m][0] * g0, a1 + acc[ai][bj][m][1] * g1);
                }
                asm volatile("" ::: "memory");
            }
    }
};


struct EpiX {
    static constexpr bool PERM = true, AFTER_DRAIN = false;
    float* X;
    __device__ __forceinline__ void operator()(const f32x4 (&acc)[2][2][4][2], const Unit& u, int wr, int wc, int fr, int fq) const {
        const int col0 = wc * 32 + 8 * fq;
#pragma unroll
        for (int ai = 0; ai < 2; ++ai)
#pragma unroll
            for (int m = 0; m < 4; ++m) {
                const int row = u.pm * BM + ai * HALF + wr * 64 + m * 16 + fr;
                *(f32x4*)(X + (size_t)row * 128 + col0) = acc[ai][0][m][0]; *(f32x4*)(X + (size_t)row * 128 + col0 + 4) = acc[ai][0][m][1];
            }
    }
};
__device__ __forceinline__ float gelu_tanh_(float x) {
    const float u = 0.7978845608028654f * (x + 0.044715f * x * x * x);
    const float e = __expf(2.f * u);
    return 0.5f * x * (2.f - 2.f * __builtin_amdgcn_rcpf(e + 1.f));
}
__device__ __forceinline__ f32x4 gelu4(const f32x4& x) { return (f32x4){gelu_tanh_(x[0]), gelu_tanh_(x[1]), gelu_tanh_(x[2]), gelu_tanh_(x[3])}; }
struct EpiY {
    static constexpr bool PERM = true, AFTER_DRAIN = false;
    bf16_t* Y;
    __device__ __forceinline__ void operator()(const f32x4 (&acc)[2][2][4][2], const Unit& u, int wr, int wc, int fr, int fq) const {
#pragma unroll
        for (int ai = 0; ai < 2; ++ai)
#pragma unroll
            for (int m = 0; m < 4; ++m) {
                const int R = u.pm * BM + ai * HALF + wr * 64 + m * 16 + fr, gg = R >> 10, b = (R >> 8) & 3, k = R & 255;
#pragma unroll
                for (int bj = 0; bj < 2; ++bj) {
                    const int c = u.pn * BM + bj * HALF + wc * 32 + 8 * fq, i = c >> 4;
                    *(u32x4*)(Y + (size_t)(b * SEQL + 32 * k + i) * 512 + 16 * gg + (c & 15)) = pack8(gelu4(acc[ai][bj][m][0]), gelu4(acc[ai][bj][m][1]));
                }
            }
    }
};
template <class Epi, class Sched, bool ALIGN_EPI = false, bool SP2 = false>
__device__ __forceinline__ void gemm_phase(PG8_LAS unsigned char* lds, const Gemm g, const Sched& S, const Epi& E) {
    int tid_ = threadIdx.x; asm volatile("" : "+v"(tid_) :: "memory");
    const int tid = tid_, wid = __builtin_amdgcn_readfirstlane(tid >> 6), lane = tid & 63, wr = wid >> 2, wc = wid & 3, fr = lane & 15, fq = lane >> 4;
    const int K = g.K, nt = K / BK;
    unsigned voffA[2], voffB[2];
#pragma unroll
    for (int i = 0; i < 2; ++i) { int R, C; stage_rc(tid * 16 + i * 8192, R, C); const int Rb = Epi::PERM ? ((R & ~31) + perm32(R & 31)) : R;
        voffA[i] = (unsigned)(R * g.lda + C) * 2u; voffB[i] = (unsigned)(Rb * g.ldb + C) * 2u; }
    const size_t kstep = (size_t)(BK * 2);
    const size_t hstepA = (size_t)HALF * g.lda * 2, hstepB = (size_t)HALF * g.ldb * 2;
    const size_t tstepA = 2 * hstepA, tstepB = 2 * hstepB;
    const unsigned ldsw = (unsigned)wid * 1024u;
    const int aoff = lds_byte(wr * 64 + fr, fq * 8), boff = lds_byte(wc * 32 + fr, fq * 8);
#define PG8_SA(b, h) (((b) * 2 + (h)) * HTB)
#define PG8_SB(b, h) ((4 + (b) * 2 + (h)) * HTB)
#define PG8_STAGE(bufoff, gbase, voff) do { _Pragma("unroll") for (int _i = 0; _i < 2; ++_i) \
        __builtin_amdgcn_global_load_lds((const unsigned*)((const char*)(gbase) + (voff)[_i]), (PG8_LAS unsigned*)(lds + (bufoff) + ldsw + _i * 8192), 16, 0, 0); } while (0)
#define PG8_LDA(dst, b, h) do { _Pragma("unroll") for (int m = 0; m < 4; ++m) _Pragma("unroll") for (int k = 0; k < 2; ++k) dst[m][k] = *(const PG8_LAS bf16x8*)(lds + PG8_SA(b, h) + aoff + m * 2048 + k * 1024); } while (0)
#define PG8_LDB(dst, b, h) do { _Pragma("unroll") for (int n = 0; n < 2; ++n) _Pragma("unroll") for (int k = 0; k < 2; ++k) dst[n][k] = *(const PG8_LAS bf16x8*)(lds + PG8_SB(b, h) + boff + n * 2048 + k * 1024); } while (0)
#define PG8_MMA(ai, bj, At, Bt) do { __builtin_amdgcn_s_setprio(1); _Pragma("unroll") for (int m = 0; m < 4; ++m) _Pragma("unroll") for (int n = 0; n < 2; ++n) _Pragma("unroll") for (int k = 0; k < 2; ++k) \
        acc[ai][bj][m][n] = __builtin_amdgcn_mfma_f32_16x16x32_bf16(Bt[n][k], At[m][k], acc[ai][bj][m][n], 0, 0, 0); __builtin_amdgcn_s_setprio(0); } while (0)
#define PG8_WAIT_V(n) asm volatile("s_waitcnt vmcnt(" #n ")" ::: "memory")
#define PG8_WAIT_L(n) asm volatile("s_waitcnt lgkmcnt(" #n ")" ::: "memory")
#define PG8_BAR __builtin_amdgcn_s_barrier()
#define PG8_SCHED __builtin_amdgcn_sched_barrier(0)
    Unit cur, nxt; int ui = 0;
    if (!S.next(0, cur)) return;
    f32x4 acc[2][2][4][2];
#pragma unroll
    for (int a = 0; a < 2; ++a)
#pragma unroll
        for (int b = 0; b < 2; ++b)
#pragma unroll
            for (int m = 0; m < 4; ++m)
#pragma unroll
                for (int n = 0; n < 2; ++n) acc[a][b][m][n] = (f32x4){0.f, 0.f, 0.f, 0.f};
    bf16x8 At[4][2], B0[2][2], B1[2][2];
    const char* cA = (const char*)g.A + (size_t)cur.pm * tstepA; const char* cB = (const char*)g.Bt + (size_t)cur.pn * tstepB + (size_t)(cur.pm / g.mtpg) * g.bgs;
    S.a_ready(cur);
    if constexpr (SP2) {
        PG8_STAGE(PG8_SB(0, 0), cB, voffB); PG8_STAGE(PG8_SB(0, 1), cB + hstepB, voffB); PG8_STAGE(PG8_SA(0, 0), cA, voffA); PG8_STAGE(PG8_SA(0, 1), cA + hstepA, voffA);
        if (wr == 1) PG8_BAR;
        PG8_WAIT_V(2); PG8_BAR;
        PG8_STAGE(PG8_SB(1, 0), cB + kstep, voffB); PG8_STAGE(PG8_SA(1, 0), cA + kstep, voffA); PG8_STAGE(PG8_SB(1, 1), cB + hstepB + kstep, voffB);
        PG8_WAIT_V(6); PG8_BAR;
    } else {
        PG8_STAGE(PG8_SB(0, 0), cB, voffB); PG8_STAGE(PG8_SA(0, 0), cA, voffA); PG8_STAGE(PG8_SB(0, 1), cB + hstepB, voffB); PG8_STAGE(PG8_SA(0, 1), cA + hstepA, voffA);
        if (wr == 1) PG8_BAR;
        PG8_WAIT_V(4); PG8_BAR;
        PG8_STAGE(PG8_SB(1, 0), cB + kstep, voffB); PG8_STAGE(PG8_SA(1, 0), cA + kstep, voffA); PG8_STAGE(PG8_SB(1, 1), cB + hstepB + kstep, voffB);
        PG8_WAIT_V(6); PG8_BAR;
    }
    for (;;) {
        const bool has_next = S.next(ui + 1, nxt);
        const char* nA = has_next ? (const char*)g.A + (size_t)nxt.pm * tstepA : cA; const char* nB = has_next ? (const char*)g.Bt + (size_t)nxt.pn * tstepB + (size_t)(nxt.pm / g.mtpg) * g.bgs : cB;
#pragma unroll 1
        for (int t = 0; t < nt; t += 2) {
            const bool last = (t == nt - 2);
            const char* a1 = cA + (size_t)(t + 1) * kstep;
            const char* a2 = last ? nA : cA + (size_t)(t + 2) * kstep; const char* b2 = last ? nB : cB + (size_t)(t + 2) * kstep;
            const char* a3 = a2 + kstep; const char* b3 = b2 + kstep;
            if (last && has_next) S.a_ready(nxt);
            if constexpr (SP2) {
            PG8_LDB(B0, 0, 0); PG8_LDB(B1, 0, 1); PG8_SCHED; PG8_LDA(At, 0, 0); PG8_STAGE(PG8_SA(1, 1), a1 + hstepA, voffA);
            PG8_WAIT_V(8); PG8_WAIT_L(0); PG8_BAR; PG8_MMA(0, 0, At, B0); PG8_MMA(0, 1, At, B1); PG8_BAR; PG8_SCHED;
            PG8_LDA(At, 0, 1); PG8_STAGE(PG8_SB(0, 0), b2, voffB); PG8_STAGE(PG8_SB(0, 1), b2 + hstepB, voffB); PG8_STAGE(PG8_SA(0, 0), a2, voffA);
            PG8_WAIT_V(8); PG8_WAIT_L(0); PG8_BAR; PG8_MMA(1, 0, At, B0); PG8_MMA(1, 1, At, B1); PG8_BAR; PG8_SCHED;
            PG8_LDB(B0, 1, 0); PG8_LDB(B1, 1, 1); PG8_SCHED; PG8_LDA(At, 1, 0); PG8_STAGE(PG8_SA(0, 1), a2 + hstepA, voffA);
            PG8_WAIT_V(8); PG8_WAIT_L(0); PG8_BAR; PG8_MMA(0, 0, At, B0); PG8_MMA(0, 1, At, B1); PG8_BAR; PG8_SCHED;
            PG8_LDA(At, 1, 1); PG8_STAGE(PG8_SB(1, 0), b3, voffB); PG8_STAGE(PG8_SB(1, 1), b3 + hstepB, voffB); PG8_STAGE(PG8_SA(1, 0), a3, voffA);
            PG8_WAIT_V(8); PG8_WAIT_L(0); PG8_BAR; PG8_MMA(1, 0, At, B0); PG8_MMA(1, 1, At, B1); PG8_BAR; PG8_SCHED;
            } else {
            PG8_LDB(B0, 0, 0); PG8_SCHED; PG8_LDA(At, 0, 0); PG8_STAGE(PG8_SA(1, 1), a1 + hstepA, voffA);
            PG8_WAIT_L(8); PG8_BAR; PG8_WAIT_L(0); PG8_MMA(0, 0, At, B0); PG8_BAR; PG8_SCHED;
            PG8_LDB(B1, 0, 1); PG8_STAGE(PG8_SB(0, 0), b2, voffB);
            PG8_BAR; PG8_WAIT_L(0); PG8_MMA(0, 1, At, B1); PG8_BAR;
            PG8_LDA(At, 0, 1); PG8_STAGE(PG8_SA(0, 0), a2, voffA);
            PG8_BAR; PG8_WAIT_L(0); PG8_MMA(1, 0, At, B0); PG8_BAR; PG8_SCHED;
            PG8_STAGE(PG8_SB(0, 1), b2 + hstepB, voffB);
            PG8_WAIT_V(6); PG8_BAR; PG8_MMA(1, 1, At, B1); PG8_BAR;
            PG8_LDB(B0, 1, 0); PG8_SCHED; PG8_LDA(At, 1, 0); PG8_STAGE(PG8_SA(0, 1), a2 + hstepA, voffA);
            PG8_WAIT_L(8); PG8_BAR; PG8_WAIT_L(0); PG8_MMA(0, 0, At, B0); PG8_BAR; PG8_SCHED;
            PG8_LDB(B1, 1, 1); PG8_STAGE(PG8_SB(1, 0), b3, voffB);
            PG8_BAR; PG8_WAIT_L(0); PG8_MMA(0, 1, At, B1); PG8_BAR;
            PG8_LDA(At, 1, 1); PG8_STAGE(PG8_SA(1, 0), a3, voffA);
            PG8_BAR; PG8_WAIT_L(0); PG8_MMA(1, 0, At, B0); PG8_BAR; PG8_SCHED;
            PG8_STAGE(PG8_SB(1, 1), b3 + hstepB, voffB);
            PG8_WAIT_V(6); PG8_BAR; PG8_MMA(1, 1, At, B1); PG8_BAR;
            }
        }
        if constexpr (ALIGN_EPI) { if (wr == 0) PG8_BAR; }
        if constexpr (!Epi::AFTER_DRAIN) { E(acc, cur, wr, wc, fr, fq); S.done(cur); }
        if (!has_next) break;
#pragma unroll
        for (int a = 0; a < 2; ++a)
#pragma unroll
            for (int b = 0; b < 2; ++b)
#pragma unroll
                for (int m = 0; m < 4; ++m)
#pragma unroll
                    for (int n = 0; n < 2; ++n) acc[a][b][m][n] = (f32x4){0.f, 0.f, 0.f, 0.f};
        cur = nxt; cA = nA; cB = nB; ++ui;
        if constexpr (ALIGN_EPI) { if (wr == 1) PG8_BAR; }
    }
    PG8_WAIT_V(0);
    if constexpr (!ALIGN_EPI) { if (wr == 0) PG8_BAR; }
    PG8_BAR;
    if constexpr (Epi::AFTER_DRAIN) { E.fused(acc, cur, wr, wc, fr, fq, lds, wid, lane); S.done(cur); }
#undef PG8_SA
#undef PG8_SB
#undef PG8_STAGE
#undef PG8_LDA
#undef PG8_LDB
#undef PG8_MMA
#undef PG8_WAIT_V
#undef PG8_WAIT_L
#undef PG8_BAR
#undef PG8_SCHED
}
}

using pg8::bf16_t; using pg8::bf16x8; using pg8::f32x4; using pg8::u32x4;
typedef float f32x2 __attribute__((ext_vector_type(2)));
typedef unsigned u32x2 __attribute__((ext_vector_type(2)));
#define LAS __attribute__((address_space(3)))
constexpr int NWAVES = 8, NTHREADS = 512;
constexpr int T = 32768, D = 1024, L = 8192, NB = 4, FF = 2816, INW = 4864, NH = 12;
constexpr float EPS = 1e-6f;
constexpr int LDS_BYTES = 147456;
constexpr int N_PHASES = 13;

constexpr size_t MiB = 1u << 20, KiB = 1u << 10;
constexpr size_t WS_SS1 = 0, WS_SS2 = 128 * KiB, WS_SS3 = 256 * KiB, WS_SSD = 384 * KiB;
constexpr size_t WS_BBAR = 576 * KiB;
constexpr size_t WS_LUT = 832 * KiB;
constexpr size_t WS_BAR = 848 * KiB;
constexpr size_t WS_APOW = 896 * KiB;
constexpr size_t WS_WGU1 = 2 * MiB, WS_WD1 = 13 * MiB, WS_WIN = WS_WD1 + 5632 * KiB, WS_WA = WS_WIN + 9728 * KiB, WS_WGLU = WS_WA + 512 * KiB,
                 WS_WS = WS_WGLU + 1 * MiB, WS_WOUT = WS_WS + 1 * MiB, WS_WGU2 = WS_WOUT + 2 * MiB, WS_WD2 = WS_WGU2 + 11 * MiB, WS_WEND = WS_WD2 + 5632 * KiB;
static_assert(WS_WEND <= 50 * MiB && WS_APOW + 32 * 64 * 66 * 4 <= 2 * MiB, "weights / control region");
constexpr size_t WS_XB = 50 * MiB;
constexpr size_t WS_OC = WS_XB, WS_YG = WS_XB + 16 * MiB, WS_X = WS_XB + 48 * MiB;
constexpr size_t WS_RA = 114 * MiB;
constexpr size_t WS_A1 = WS_RA, WS_Q = WS_RA, WS_K = WS_RA + 48 * MiB, WS_VT = WS_RA + 96 * MiB, WS_BTX = WS_RA + 144 * MiB, WS_BTY = WS_RA + 152 * MiB;
constexpr size_t WS_M1 = WS_RA, WS_YS = WS_RA + 64 * MiB, WS_MG = WS_RA + 96 * MiB;
constexpr size_t WS_G = 290 * MiB;
constexpr size_t WS_OG = 418 * MiB, WS_LSE = 466 * MiB, WS_AY = 468 * MiB, WS_END = 508 * MiB;
constexpr int CN = 32, AYP = 640;
constexpr size_t BAR_ZERO_BYTES = 16 * KiB;
#define XB_TMO      128
#define XB_XCNT(j)  (256  + 64 * (j))
#define XB_XSUB(j)  (1280 + 64 * (j))
#define XB_XGEN(j)  (2304 + 64 * (j))
#define XB_TOP      3328
#define XB_TOPGEN   3392
#define XCD_BAR_WORDS 3456
#define XB_SPIN_CAP (1u << 18)

__device__ __forceinline__ unsigned xb_ld(unsigned* p)              { return __hip_atomic_load(p, __ATOMIC_RELAXED, __HIP_MEMORY_SCOPE_AGENT); }
__device__ __forceinline__ unsigned xb_add(unsigned* p, unsigned v) { return __hip_atomic_fetch_add(p, v, __ATOMIC_RELAXED, __HIP_MEMORY_SCOPE_AGENT); }
__device__ __forceinline__ unsigned xb_xcc_id() { return (unsigned)__builtin_amdgcn_s_getreg((3 << 11) | 20) & 0xFu; }
#define XB_SPIN(cond, bar) do { unsigned _sp = 0; while (cond) { __builtin_amdgcn_s_sleep(1); \
    if ((++_sp & 255u) == 0u) { if (xb_ld(&(bar)[XB_TMO])) break; if (_sp > XB_SPIN_CAP) { atomicAdd(&(bar)[XB_TMO], 1u); break; } } } } while (0)

struct XcdBarrier {
    unsigned* bar; unsigned x;
    volatile LAS unsigned* st;
};

__device__ __forceinline__ XcdBarrier xcd_barrier_post(unsigned* bar, volatile LAS unsigned* st) {
    XcdBarrier b; b.bar = bar; b.x = xb_xcc_id(); b.st = st;
    if (threadIdx.x == 0) (void)xb_add(&bar[XB_XCNT(b.x)], 1u);
    return b;
}
__device__ __forceinline__ void xcd_barrier_complete(unsigned* bar, unsigned x, unsigned& nloc, unsigned& nx) {
    const unsigned G = gridDim.x * gridDim.y * gridDim.z;
    unsigned sum, cnt, mine, sp = 0u;
    for (;;) {
        sum = 0u; cnt = 0u; mine = 0u;
#pragma unroll
        for (unsigned j = 0; j < 16; ++j) { const unsigned c = xb_ld(&bar[XB_XCNT(j)]); sum += c; cnt += (c > 0u) ? 1u : 0u; mine = (j == x) ? c : mine; }
        if (sum == G) break;
        __builtin_amdgcn_s_sleep(1);
        if ((++sp & 255u) == 0u) { if (xb_ld(&bar[XB_TMO])) break; if (sp > XB_SPIN_CAP) { atomicAdd(&bar[XB_TMO], 1u); break; } }
    }
    nloc = mine > 0u ? mine : 1u; nx = cnt > 0u ? cnt : 1u;
}

__device__ __forceinline__ void xcd_barrier(const XcdBarrier& b) {
    asm volatile("s_waitcnt vmcnt(0)" ::: "memory");
    __syncthreads();
    if (threadIdx.x == 0) {
        unsigned* bar = b.bar;
        __builtin_amdgcn_s_waitcnt(0);
        unsigned nloc = b.st[0], nx = b.st[1];
        if (nloc == 0u) { xcd_barrier_complete(bar, b.x, nloc, nx); b.st[0] = nloc; b.st[1] = nx; }
        const unsigned old = xb_add(&bar[XB_XSUB(b.x)], 1u);
        const unsigned gen = old / nloc;
        if (old + 1u == (gen + 1u) * nloc) {
            __builtin_amdgcn_fence(__ATOMIC_RELEASE, "agent");
            asm volatile("s_waitcnt vmcnt(0)" ::: "memory");
            const unsigned og = xb_add(&bar[XB_TOP], 1u);
            const unsigned tg = og / nx;
            if (og + 1u == (tg + 1u) * nx) xb_add(&bar[XB_TOPGEN], 1u);
            else XB_SPIN(xb_ld(&bar[XB_TOPGEN]) == tg, bar);
            __builtin_amdgcn_fence(__ATOMIC_ACQUIRE, "agent");
            xb_add(&bar[XB_XGEN(b.x)], 1u);
            asm volatile("s_waitcnt vmcnt(0)" ::: "memory");
        } else {
            XB_SPIN(xb_ld(&bar[XB_XGEN(b.x)]) == gen, bar);
            __builtin_amdgcn_fence(__ATOMIC_ACQUIRE, "agent");
            asm volatile("s_waitcnt vmcnt(0)" ::: "memory");
        }
    }
    __syncthreads();
}

struct Params { const float* in[26]; float* out; unsigned char* ws; int ph_lo, ph_hi; unsigned char bk[3][136]; };

__device__ __forceinline__ float wave_sum(float v) {
#pragma unroll
    for (int o = 1; o < 64; o <<= 1) v += __shfl_xor(v, o);
    return v;
}
__device__ __forceinline__ unsigned f2bf(float f) { unsigned u = __builtin_bit_cast(unsigned, f); return (u + 0x7fffu + ((u >> 16) & 1u)) >> 16; }
__device__ __forceinline__ unsigned pk2(float lo, float hi) { return f2bf(lo) | (f2bf(hi) << 16); }
#define LDS_WAIT() asm volatile("s_waitcnt lgkmcnt(0)" ::: "memory")

__device__ __forceinline__ void transpose_item(const float* W, int K, int N, bf16_t* WT, int k0, int n0, int rowbase, const float* gain, LAS float* scr, int lane) {
#pragma unroll 8
    for (int i = 0; i < 32; ++i) { const int kk = 2 * i + (lane >> 5); float v = W[(size_t)(k0 + kk) * N + n0 + (lane & 31)]; if (gain) v *= gain[k0 + kk]; scr[kk * 33 + (lane & 31)] = v; }
    LDS_WAIT();
    const int c = lane & 7;
#pragma unroll
    for (int j = 0; j < 4; ++j) { const int n = (lane >> 3) + 8 * j; const LAS float* s = scr + (8 * c) * 33 + n;
        u32x4 o; o.x = pk2(s[0 * 33], s[1 * 33]); o.y = pk2(s[2 * 33], s[3 * 33]); o.z = pk2(s[4 * 33], s[5 * 33]); o.w = pk2(s[6 * 33], s[7 * 33]);
        *(u32x4*)(WT + (size_t)(rowbase + n) * K + k0 + 8 * c) = o; }
    LDS_WAIT();
}
__device__ __forceinline__ int tdesc_row(int mode, int N, int n0) {
    if (mode == 0) return n0;
    if (mode == 1) return (n0 >> 7) * 256 + (n0 & 127);
    if (mode == 2) return (n0 >> 7) * 256 + 128 + (n0 & 127);
    const int half = N >> 1; const int j = n0 < half ? n0 : n0 - half; return (j >> 7) * 256 + (n0 < half ? 0 : 128) + (j & 127);
}

__device__ __forceinline__ float gelu_tanh(float x) {
    const float u = 0.7978845608028654f * (x + 0.044715f * x * x * x);
    const float e = __expf(2.f * u);
    const float th = 1.f - 2.f * __builtin_amdgcn_rcpf(e + 1.f);
    return 0.5f * x * (1.f + th);
}

__device__ __forceinline__ pg8::Gemm mk_gemm(const bf16_t* A, const bf16_t* Bt, int M, int N, int K) { return pg8::Gemm{A, Bt, M, N, K, K, K, 1 << 30, (size_t)0}; }

__global__ void __launch_bounds__(NTHREADS, 2) fwd_kernel(Params P) {
    extern __shared__ __attribute__((aligned(16))) unsigned char lds_raw[];
    LAS unsigned char* lds = (LAS unsigned char*)lds_raw;
    const int tid = threadIdx.x, lane = tid & 63, wave = __builtin_amdgcn_readfirstlane(tid >> 6);
    const int G = gridDim.x, bid = blockIdx.x;
    const int gw = bid * NWAVES + wave, NGW = G * NWAVES;
    unsigned char* ws = P.ws;
    float* ss1 = (float*)(ws + WS_SS1); float* ss2 = (float*)(ws + WS_SS2); float* ss3 = (float*)(ws + WS_SS3);
    float* bbar = (float*)(ws + WS_BBAR); float* lutg = (float*)(ws + WS_LUT); float* apow = (float*)(ws + WS_APOW);
    bf16_t* Wgu1 = (bf16_t*)(ws + WS_WGU1); bf16_t* Wd1 = (bf16_t*)(ws + WS_WD1); bf16_t* Win = (bf16_t*)(ws + WS_WIN); bf16_t* Wa = (bf16_t*)(ws + WS_WA);
    bf16_t* Wglu = (bf16_t*)(ws + WS_WGLU); bf16_t* Wsb = (bf16_t*)(ws + WS_WS); bf16_t* Wout = (bf16_t*)(ws + WS_WOUT); bf16_t* Wgu2 = (bf16_t*)(ws + WS_WGU2); bf16_t* Wd2 = (bf16_t*)(ws + WS_WD2);
    bf16_t* XB = (bf16_t*)(ws + WS_XB); bf16_t* Oc = (bf16_t*)(ws + WS_OC); bf16_t* Yg = (bf16_t*)(ws + WS_YG); float* Xs = (float*)(ws + WS_X);
    bf16_t* A1 = (bf16_t*)(ws + WS_A1); bf16_t* Qp = (bf16_t*)(ws + WS_Q); bf16_t* Kp = (bf16_t*)(ws + WS_K); bf16_t* Vtp = (bf16_t*)(ws + WS_VT);
    bf16_t* BtX = (bf16_t*)(ws + WS_BTX); bf16_t* BtY = (bf16_t*)(ws + WS_BTY); bf16_t* AY = (bf16_t*)(ws + WS_AY);
    bf16_t* M1 = (bf16_t*)(ws + WS_M1); bf16_t* Ys = (bf16_t*)(ws + WS_YS); bf16_t* MG = (bf16_t*)(ws + WS_MG);
    bf16_t* Gt = (bf16_t*)(ws + WS_G); bf16_t* Og = (bf16_t*)(ws + WS_OG); float* LSE = (float*)(ws + WS_LSE);
    const float* x = P.in[0];
    float* dumF = (float*)(ws + WS_G); bf16_t* dumB = (bf16_t*)(ws + WS_M1); float* ssd = (float*)(ws + WS_SSD);
    float* out = P.out;
    const int lo = P.ph_lo, hi = P.ph_hi;
    volatile LAS unsigned* misc = (volatile LAS unsigned*)(lds + 131072 + 64);
    if (tid < 2) misc[tid] = 0u;
    __syncthreads();
    XcdBarrier bar; bar.bar = (unsigned*)(ws + WS_BAR); bar.x = 0; bar.st = nullptr;
    if (hi - lo > 1) bar = xcd_barrier_post((unsigned*)(ws + WS_BAR), misc);
#ifndef REPEAT_PH
#define REPEAT_PH (-1)
#endif
#ifndef REPEAT_N
#define REPEAT_N 1
#endif
#define REPS(k) (((k) == REPEAT_PH) ? 1 + REPEAT_N : 1)
#ifndef PHMASK
#define PHMASK 0xFFFF
#endif
#define IN_PH(k) ((((PHMASK) >> (k)) & 1) && lo <= (k) && (k) < hi)
#define SEAM(k) do { if (IN_PH(k) && IN_PH((k) + 1)) { if ((k) == 0) cg::this_grid().sync(); else xcd_barrier(bar); } } while (0)

    if (IN_PH(0)) for (int rep = 0; rep < REPS(0); ++rep) {
        LAS float* scr = (LAS float*)(lds + wave * 16384);
        int itbase = 0;
#define DO_MAT(Wp, Kd, Nd, WTp, MODE, GAIN) do { const int nblk = (Nd) / 32, nit = ((Kd) / 64) * nblk; const int first = (gw - (itbase % NGW) + NGW) % NGW; \
            for (int it = first; it < nit; it += NGW) { const int kb = it / nblk, nb = it % nblk; transpose_item((Wp), (Kd), (Nd), (WTp), 64 * kb, 32 * nb, tdesc_row((MODE), (Nd), 32 * nb), (GAIN), scr, lane); } \
            itbase += nit; } while (0)
        DO_MAT(P.in[2], D, FF, Wgu1, 1, (const float*)nullptr); DO_MAT(P.in[3], D, FF, Wgu1, 2, (const float*)nullptr); DO_MAT(P.in[4], FF, D, Wd1, 0, (const float*)nullptr);
        DO_MAT(P.in[6], D, INW, Win, 0, P.in[5]); DO_MAT(P.in[18], 256, D, Wa, 0, (const float*)nullptr); DO_MAT(P.in[17], 512, D, Wglu, 3, (const float*)nullptr);
        DO_MAT(P.in[19], 512, D, Wsb, 0, (const float*)nullptr); DO_MAT(P.in[20], D, D, Wout, 0, (const float*)nullptr);
        DO_MAT(P.in[22], D, FF, Wgu2, 1, P.in[21]); DO_MAT(P.in[23], D, FF, Wgu2, 2, P.in[21]); DO_MAT(P.in[24], FF, D, Wd2, 0, (const float*)nullptr);
#undef DO_MAT
        { const float* g1 = P.in[1];
          for (int r = gw; r < T; r += NGW) {
            const f32x4* xr = (const f32x4*)(x + (size_t)r * D) + lane; f32x4 v[4]; float s = 0.f;
#pragma unroll
            for (int j = 0; j < 4; ++j) { v[j] = xr[64 * j]; s += (v[j][0] * v[j][0] + v[j][1] * v[j][1]) + (v[j][2] * v[j][2] + v[j][3] * v[j][3]); }
            const float rinv = 1.0f / sqrtf(wave_sum(s) * (1.0f / D) + EPS);
            u32x2* o8 = (u32x2*)(XB + (size_t)r * D) + lane;
#pragma unroll
            for (int j = 0; j < 4; ++j) { const f32x4 gg = ((const f32x4*)g1)[lane + 64 * j]; u32x2 w; w.x = pk2(v[j][0] * rinv * gg[0], v[j][1] * rinv * gg[1]); w.y = pk2(v[j][2] * rinv * gg[2], v[j][3] * rinv * gg[3]); o8[64 * j] = w; }
          } }
        for (int i = bid * NTHREADS + tid; i < 3 * T; i += G * NTHREADS) ((float*)(ws + WS_SS1))[i] = 0.f;
        for (int i = bid * NTHREADS + tid; i < 32 * 64; i += G * NTHREADS) {
            const int g = i >> 6;
            const float dt = expf(P.in[11][g]), lre = P.in[9][i], lim = P.in[10][i];
            const float zr = lre * dt, zi = lim * dt, em1 = expm1f(zr), mag = em1 + 1.0f, cz = cosf(zi), sz = sinf(zi), sh = sinf(0.5f * zi);
            const float abim = mag * sz;
            const float xr = em1 * cz - 2.0f * sh * sh;
            const float den = lre * lre + lim * lim;
            const float cre = (xr * lre + abim * lim) / den, cim = (abim * lre - xr * lim) / den;
            for (int p = 0; p <= 32; ++p) { const float mp = expf(zr * (float)p), ang = zi * (float)p; apow[(size_t)i * 66 + 2 * p] = mp * cosf(ang); apow[(size_t)i * 66 + 2 * p + 1] = mp * sinf(ang); }
            for (int c = 0; c < 16; ++c) { const float br = P.in[12][i * 16 + c], bi = P.in[13][i * 16 + c];
                bbar[i * 32 + c] = cre * br - cim * bi; bbar[i * 32 + 16 + c] = cre * bi + cim * br; }
        }
        for (int i = bid * NTHREADS + tid; i < 12 * 132; i += G * NTHREADS) { const int h = i / 132, s = i % 132; lutg[i] = (s <= 128) ? P.in[8][(int)P.bk[h >> 2][s] * 12 + h] : 0.f; }
    }
    SEAM(0);

    if (IN_PH(1)) for (int rep = 0; rep < REPS(1); ++rep) {
        const pg8::Gemm g = mk_gemm(XB, Wgu1, T, 2 * FF, D); pg8::StaticOrder S; S.init(T, 2 * FF, G, bid);
        pg8::EpiSwiglu E{A1, FF, nullptr};
        pg8::gemm_phase<pg8::EpiSwiglu, pg8::StaticOrder, true, true>(lds, g, S, E);
    }
    SEAM(1);
    if (IN_PH(2)) for (int rep = 0; rep < REPS(2); ++rep) {
        const pg8::Gemm g = mk_gemm(A1, Wd1, T, D, FF); pg8::StaticOrder S; S.init(T, D, G, bid);
        pg8::EpiResid E{x, rep ? dumF : out, XB, rep ? ssd : ss1, 0.5f};
        pg8::gemm_phase<pg8::EpiResid, pg8::StaticOrder, true, true>(lds, g, S, E);
    }
    SEAM(2);
    if (IN_PH(3)) for (int rep = 0; rep < REPS(3); ++rep) {
        const float* cre_g = P.in[14]; const float* cim_g = P.in[15]; const float* dsk = P.in[16];
        for (int i = bid * NTHREADS + tid; i < 32 * 64 * 32; i += G * NTHREADS) {
            const int ip = i & 31, gn = i >> 5, g = gn >> 6, n = gn & 63;
            const float wr_ = apow[(size_t)gn * 66 + 2 * (31 - ip)], wi_ = apow[(size_t)gn * 66 + 2 * (31 - ip) + 1];
            f32x4 br[4], bi[4];
#pragma unroll
            for (int q = 0; q < 4; ++q) { br[q] = *(const f32x4*)(bbar + gn * 32 + 4 * q); bi[q] = *(const f32x4*)(bbar + gn * 32 + 16 + 4 * q); }
            bf16_t* r0 = BtX + ((size_t)(g * 256 + 2 * n) * 512 + ip * 16);
            *(u32x4*)(r0) = pg8::pack8(br[0] * wr_ - bi[0] * wi_, br[1] * wr_ - bi[1] * wi_); *(u32x4*)(r0 + 8) = pg8::pack8(br[2] * wr_ - bi[2] * wi_, br[3] * wr_ - bi[3] * wi_);
            *(u32x4*)(r0 + 512) = pg8::pack8(bi[0] * wr_ + br[0] * wi_, bi[1] * wr_ + br[1] * wi_); *(u32x4*)(r0 + 512 + 8) = pg8::pack8(bi[2] * wr_ + br[2] * wi_, bi[3] * wr_ + br[3] * wi_);
        }
        for (int i = bid * NTHREADS + tid; i < 32 * 128 * 64; i += G * NTHREADS) { const int g = i >> 13, r = (i >> 6) & 127, c8 = i & 63; *(u32x4*)(BtX + ((size_t)(g * 256 + 128 + r) * 512 + c8 * 8)) = (u32x4){0u, 0u, 0u, 0u}; }
        for (int i = bid * NTHREADS + tid; i < 32 * 512 * 64; i += G * NTHREADS) {
            const int n = i & 63, row = (i >> 6) & 511, g = i >> 15, ii = row >> 4, co = row & 15;
            const float wr_ = apow[(size_t)(g * 64 + n) * 66 + 2 * (ii + 1)], wi_ = apow[(size_t)(g * 64 + n) * 66 + 2 * (ii + 1) + 1];
            const float cr = cre_g[(g * 16 + co) * 64 + n], ci = cim_g[(g * 16 + co) * 64 + n];
            *(unsigned*)(BtY + ((size_t)(g * 512 + row) * AYP + 512 + 2 * n)) = pg8::cvt_pk_bf16(cr * wr_ - ci * wi_, -(cr * wi_ + ci * wr_));
        }
        for (int it = gw; it < 32 * 63; it += NGW) {
            const int g = it / 63, tau = it - g * 63 - 31, ci = lane & 15, coq = lane >> 4;
            float kv[4] = {0.f, 0.f, 0.f, 0.f};
            if (tau >= 0) {
#pragma unroll 4
                for (int n = 0; n < 64; ++n) {
                    const int gn = g * 64 + n;
                    const float wr_ = apow[(size_t)gn * 66 + 2 * tau], wi_ = apow[(size_t)gn * 66 + 2 * tau + 1];
                    const float br = bbar[gn * 32 + ci], bi = bbar[gn * 32 + 16 + ci];
                    const float tr = wr_ * br - wi_ * bi, ti = wr_ * bi + wi_ * br;
#pragma unroll
                    for (int j = 0; j < 4; ++j) { const int co = coq + 4 * j; kv[j] += cre_g[(g * 16 + co) * 64 + n] * tr - cim_g[(g * 16 + co) * 64 + n] * ti; }
                }
                if (tau == 0) {
#pragma unroll
                    for (int j = 0; j < 4; ++j) if (coq + 4 * j == ci) kv[j] += dsk[16 * g + ci];
                }
            }
            const int at = tau < 0 ? -tau : tau;
#pragma unroll
            for (int j = 0; j < 4; ++j) {
                const bf16_t hv = (bf16_t)f2bf(kv[j]); const int co = coq + 4 * j;
                for (int q = 0; q < 32 - at; ++q) { const int ii = tau >= 0 ? q + tau : q, ip = tau >= 0 ? q : q + at; BtY[(size_t)(g * 512 + ii * 16 + co) * AYP + ip * 16 + ci] = hv; }
            }
        }
        const pg8::Gemm g = mk_gemm(XB, Win, T, INW, D); pg8::StaticOrder S; S.init(T, INW, G, bid);
        pg8::EpiZ E{Qp, Kp, Vtp, AY, Gt, ss1, P.in[7]};
        pg8::gemm_phase<pg8::EpiZ, pg8::StaticOrder, true, true>(lds, g, S, E);
    }
    SEAM(3);
    if (IN_PH(4)) for (int rep = 0; rep < REPS(4); ++rep) {
        { const pg8::Gemm g{AY, BtX, T, 256, 512, AYP, 512, 4, (size_t)256 * 512 * 2}; pg8::StaticOrder S; S.init(T, 256, G, bid);
          pg8::EpiX E{Xs};
          pg8::gemm_phase<pg8::EpiX, pg8::StaticOrder, true, true>(lds, g, S, E); }
        __syncthreads();
        LAS float* lut = (LAS float*)lds;
        for (int i = tid; i < 12 * 132; i += NTHREADS) lut[i] = lutg[i];
        __syncthreads();
        const int fr = lane & 15, fq = lane >> 4;
        for (int bu = bid; bu < NB * NH * 64; bu += G) {
            const int bh = bu >> 6, blk = bu & 63, b = bh / NH, h = bh - b * NH, g = h >> 2, sh = 2 * g, lm = 13 - sh, Msub = 1 << lm;
            const int tq0 = blk * 128 + 16 * wave, r = tq0 >> lm, m0 = tq0 & (Msub - 1);
            const bf16_t* Qb = Qp + (size_t)bh * L * 64; const bf16_t* Kb = Kp + (size_t)bh * L * 64; const bf16_t* Vb = Vtp + (size_t)bh * 64 * L;
            const LAS float* luth = lut + h * 132;
            bf16x8 qf[2];
#pragma unroll
            for (int ks = 0; ks < 2; ++ks) qf[ks] = *(const bf16x8*)(Qb + (size_t)(tq0 + fr) * 64 + 32 * ks + 8 * fq);
            float s[9][4];
#pragma unroll
            for (int kt = 1; kt <= 9; ++kt) {
                const int kb = m0 - 144 + 16 * kt;
                if (kb >= 0) {
                    const bf16_t* kp = Kb + (size_t)((r << lm) + kb + fr) * 64 + 8 * fq;
                    const bf16x8 k0 = *(const bf16x8*)kp, k1 = *(const bf16x8*)(kp + 32);
                    f32x4 a = (f32x4){0.f, 0.f, 0.f, 0.f};
                    a = __builtin_amdgcn_mfma_f32_16x16x32_bf16(k0, qf[0], a, 0, 0, 0);
                    a = __builtin_amdgcn_mfma_f32_16x16x32_bf16(k1, qf[1], a, 0, 0, 0);
#pragma unroll
                    for (int i = 0; i < 4; ++i) { const int st = (m0 + fr) - (kb + 4 * fq + i); const bool ok = (st >= 0) && (st <= 128);
                        const int sc = st < 0 ? 0 : (st > 128 ? 128 : st); s[kt - 1][i] = ok ? a[i] + luth[sc] : -1e30f; }
                } else {
#pragma unroll
                    for (int i = 0; i < 4; ++i) s[kt - 1][i] = -1e30f;
                }
            }
            float mx = -1e30f;
#pragma unroll
            for (int kt = 0; kt < 9; ++kt)
#pragma unroll
                for (int i = 0; i < 4; ++i) mx = fmaxf(mx, s[kt][i]);
            mx = fmaxf(mx, __shfl_xor(mx, 16)); mx = fmaxf(mx, __shfl_xor(mx, 32));
            float lsum = 0.f;
#pragma unroll
            for (int kt = 0; kt < 9; ++kt)
#pragma unroll
                for (int i = 0; i < 4; ++i) { s[kt][i] = __expf(s[kt][i] - mx); lsum += s[kt][i]; }
            lsum += __shfl_xor(lsum, 16); lsum += __shfl_xor(lsum, 32);
            f32x4 oacc[4];
#pragma unroll
            for (int dt = 0; dt < 4; ++dt) oacc[dt] = (f32x4){0.f, 0.f, 0.f, 0.f};
#pragma unroll
            for (int kp = 0; kp < 5; ++kp) {
                const int kb0 = m0 - 144 + 32 * kp, kb1 = kb0 + 16;
                u32x4 pw;
                if (kp == 0) { pw.x = 0u; pw.y = 0u; } else { pw.x = pg8::cvt_pk_bf16(s[2 * kp - 1][0], s[2 * kp - 1][1]); pw.y = pg8::cvt_pk_bf16(s[2 * kp - 1][2], s[2 * kp - 1][3]); }
                pw.z = pg8::cvt_pk_bf16(s[2 * kp][0], s[2 * kp][1]); pw.w = pg8::cvt_pk_bf16(s[2 * kp][2], s[2 * kp][3]);
                const bf16x8 pf = __builtin_bit_cast(bf16x8, pw);
                if (kb1 >= 0) {
#pragma unroll
                    for (int dt = 0; dt < 4; ++dt) {
                        const bf16_t* vp = Vb + (size_t)(16 * dt + fr) * L + (r << lm) + kb0 + 4 * fq;
                        u32x2 lo2 = (u32x2){0u, 0u};
                        if (kp > 0 && kb0 >= 0) lo2 = *(const u32x2*)vp;
                        const u32x2 hi2 = *(const u32x2*)(vp + 16);
                        const u32x4 vw = (u32x4){lo2.x, lo2.y, hi2.x, hi2.y};
                        oacc[dt] = __builtin_amdgcn_mfma_f32_16x16x32_bf16(__builtin_bit_cast(bf16x8, vw), pf, oacc[dt], 0, 0, 0);
                    }
                }
            }
            const float inv = 1.0f / lsum;
            const int tok = b * L + ((m0 + fr) << sh) + r;
            bf16_t* op = Og + ((size_t)g * T + tok) * 256 + (h & 3) * 64 + 4 * fq;
#pragma unroll
            for (int dt = 0; dt < 4; ++dt) { u32x2 w; w.x = pg8::cvt_pk_bf16(oacc[dt][0] * inv, oacc[dt][1] * inv); w.y = pg8::cvt_pk_bf16(oacc[dt][2] * inv, oacc[dt][3] * inv); *(u32x2*)(op + 16 * dt) = w; }
            if (fq == 0) LSE[((size_t)g * T + tok) * 4 + (h & 3)] = mx + __logf(lsum);
        }
        __syncthreads();
    }
    SEAM(4);
    if (IN_PH(5)) for (int rep = 0; rep < REPS(5); ++rep) {
        const int nsb = G < 128 ? G : 128;
        const bool scan_wave = (bid < 128 && wave == 0);
        if (scan_wave) {
          for (int item = bid; item < 128; item += G) {
            const int b = item >> 5, g = item & 31, gn = g * 64 + lane;
            const float a32r = apow[(size_t)gn * 66 + 64], a32i = apow[(size_t)gn * 66 + 65];
            float sre = 0.f, sim = 0.f;
            const size_t R0 = (size_t)(g * 1024 + b * 256);
#pragma unroll 16
            for (int k = 0; k < 256; ++k) {
                *(unsigned*)(AY + (R0 + k) * AYP + 512 + 2 * lane) = pg8::cvt_pk_bf16(sre, sim);
                const f32x2 xv = *(const f32x2*)(Xs + (R0 + k) * 128 + 2 * lane);
                const float nr = a32r * sre - a32i * sim + xv[0], ni = a32r * sim + a32i * sre + xv[1]; sre = nr; sim = ni;
            }
          }
        } else {
            const int NCW = NGW - nsb;
            const int cw = bid < nsb ? bid * 7 + wave - 1 : nsb * 7 + (bid - nsb) * 8 + wave;
            for (int it = cw; it < T / 2; it += NCW) {
                const int tok = it * 2 + (lane >> 5), ch = lane & 31, j = ch >> 3;
                const float l0 = LSE[((size_t)0 * T + tok) * 4 + j], l1 = LSE[((size_t)1 * T + tok) * 4 + j], l2 = LSE[((size_t)2 * T + tok) * 4 + j];
                const float mx = fmaxf(l0, fmaxf(l1, l2)); const float e0 = __expf(l0 - mx), e1 = __expf(l1 - mx), e2 = __expf(l2 - mx); const float inv = 1.0f / (e0 + e1 + e2);
                f32x4 a0, a1, b0, b1, c0, c1;
                pg8::unpack8(*(const u32x4*)(Og + ((size_t)0 * T + tok) * 256 + 8 * ch), a0, a1);
                pg8::unpack8(*(const u32x4*)(Og + ((size_t)1 * T + tok) * 256 + 8 * ch), b0, b1);
                pg8::unpack8(*(const u32x4*)(Og + ((size_t)2 * T + tok) * 256 + 8 * ch), c0, c1);
                const float w0 = e0 * inv, w1 = e1 * inv, w2 = e2 * inv;
                *(u32x4*)(Oc + (size_t)tok * 256 + 8 * ch) = pg8::pack8(a0 * w0 + b0 * w1 + c0 * w2, a1 * w0 + b1 * w1 + c1 * w2);
            }
        }
        __syncthreads();
    }
    SEAM(5);
    if (IN_PH(6)) for (int rep = 0; rep < REPS(6); ++rep) {
        { const pg8::Gemm g{AY, BtY, T, 512, AYP, AYP, AYP, 4, (size_t)512 * AYP * 2}; pg8::StaticOrder S; S.init(T, 512, G, bid);
          pg8::EpiY E{Yg};
          pg8::gemm_phase<pg8::EpiY, pg8::StaticOrder, true, true>(lds, g, S, E); }
        { const pg8::Gemm g = mk_gemm(Oc, Wa, T, D, 256); pg8::StaticOrder S; S.init(T, D, G, bid);
          pg8::EpiGateMul E{M1, Gt};
          pg8::gemm_phase<pg8::EpiGateMul, pg8::StaticOrder, true, true>(lds, g, S, E); }
    }
    SEAM(6);
    if (IN_PH(7)) for (int rep = 0; rep < REPS(7); ++rep) {
        const pg8::Gemm g = mk_gemm(Yg, Wglu, T, D, 512); pg8::StaticOrder S; S.init(T, D, G, bid);
        pg8::EpiGlu E{Ys};
        pg8::gemm_phase<pg8::EpiGlu, pg8::StaticOrder, true, true>(lds, g, S, E);
    }
    SEAM(7);
    if (IN_PH(8)) for (int rep = 0; rep < REPS(8); ++rep) {
        const pg8::Gemm g = mk_gemm(Ys, Wsb, T, D, 512); pg8::StaticOrder S; S.init(T, D, G, bid);
        pg8::EpiMerge E{MG, M1, Gt + 1024};
        pg8::gemm_phase<pg8::EpiMerge, pg8::StaticOrder, true, true>(lds, g, S, E);
    }
    SEAM(8);
    if (IN_PH(9)) for (int rep = 0; rep < REPS(9); ++rep) {
        const pg8::Gemm g = mk_gemm(MG, Wout, T, D, D); pg8::StaticOrder S; S.init(T, D, G, bid);
        pg8::EpiResid E{out, rep ? dumF : out, rep ? dumB : XB, rep ? ssd : ss2, 1.0f};
        pg8::gemm_phase<pg8::EpiResid, pg8::StaticOrder, true, true>(lds, g, S, E);
    }
    SEAM(9);
    if (IN_PH(10)) for (int rep = 0; rep < REPS(10); ++rep) {
        const pg8::Gemm g = mk_gemm(XB, Wgu2, T, 2 * FF, D); pg8::StaticOrder S; S.init(T, 2 * FF, G, bid);
        pg8::EpiSwiglu E{A1, FF, ss2};
        pg8::gemm_phase<pg8::EpiSwiglu, pg8::StaticOrder, true, true>(lds, g, S, E);
    }
    SEAM(10);
    if (IN_PH(11)) for (int rep = 0; rep < REPS(11); ++rep) {
        const pg8::Gemm g = mk_gemm(A1, Wd2, T, D, FF); pg8::StaticOrder S; S.init(T, D, G, bid);
        pg8::EpiResid E{out, rep ? dumF : out, nullptr, rep ? ssd : ss3, 0.5f};
        pg8::gemm_phase<pg8::EpiResid, pg8::StaticOrder, true, true>(lds, g, S, E);
    }
    SEAM(11);
    if (IN_PH(12)) for (int rep = 0; rep < REPS(12); ++rep) {
        const float* gf = P.in[25];
        for (int r = gw; r < T; r += NGW) {
            const float rinv = 1.0f / sqrtf(ss3[r] * (1.0f / D) + EPS);
            f32x4* xr = (f32x4*)(out + (size_t)r * D) + lane; f32x4* xw = (f32x4*)((rep ? dumF : out) + (size_t)r * D) + lane;
#pragma unroll
            for (int j = 0; j < 4; ++j) { const f32x4 gg = ((const f32x4*)gf)[lane + 64 * j]; xw[64 * j] = xr[64 * j] * rinv * gg; }
        }
    }
#undef IN_PH
#undef SEAM
}

extern "C" void kernel_launch(void* const* d_in, const int* in_sizes, int n_in, void* d_out, int out_size, void* d_ws, size_t ws_size, hipStream_t stream) {
    static int grid = 0;
    if (grid == 0) {
        if (n_in != 26 || ws_size < WS_END) { fprintf(stderr, "kernel_launch: expected 26 inputs and >= %zu bytes of workspace; got %d, %zu\n", (size_t)WS_END, n_in, ws_size); grid = -1; return; }
        int dev = 0, cus = 0, per_cu = 0;
        (void)hipGetDevice(&dev); (void)hipDeviceGetAttribute(&cus, hipDeviceAttributeMultiprocessorCount, dev);
        if (hipFuncSetAttribute((const void*)fwd_kernel, hipFuncAttributeMaxDynamicSharedMemorySize, LDS_BYTES) != hipSuccess) { fprintf(stderr, "kernel_launch: hipFuncSetAttribute failed\n"); grid = -1; return; }
        (void)hipOccupancyMaxActiveBlocksPerMultiprocessor(&per_cu, (const void*)fwd_kernel, NTHREADS, LDS_BYTES);
        if (per_cu < 1) { fprintf(stderr, "kernel_launch: occupancy query says %d blocks per CU\n", per_cu); per_cu = 1; }
        (void)hipGetLastError();
        grid = cus;
        fprintf(stderr, "kernel_launch: grid %d (CUs %d, occupancy %d per CU)\n", grid, cus, per_cu);
    }
    if (grid < 0) return;
    Params p{};
    for (int i = 0; i < 26; ++i) p.in[i] = (const float*)d_in[i];
    p.out = (float*)d_out; p.ws = (unsigned char*)d_ws;
    for (int g = 0; g < 3; ++g) { const int dil = g == 0 ? 1 : (g == 1 ? 4 : 16);
        for (int s = 0; s <= 128; ++s) { const int dist = s * dil; int bkt;
            if (dist < 16) bkt = dist; else { const float dd = (float)dist; int large = 16 + (int)(logf(dd / 16.0f) / (float)log(128.0) * 16.0f); if (large > 31) large = 31; bkt = large; }
            p.bk[g][s] = (unsigned char)bkt; } }
#if ONE_LAUNCH
    if (hipMemsetAsync((char*)d_ws + WS_BAR, 0, BAR_ZERO_BYTES, stream) != hipSuccess) { fprintf(stderr, "kernel_launch: memset failed\n"); return; }
    p.ph_lo = 0; p.ph_hi = N_PHASES;
    void* args[] = {&p};
    hipError_t e = hipLaunchCooperativeKernel((const void*)fwd_kernel, dim3(grid), dim3(NTHREADS), args, LDS_BYTES, stream);
    if (e != hipSuccess) fprintf(stderr, "cooperative launch failed: %s (grid %d)\n", hipGetErrorString(e), grid);
#else
    for (int ph = 0; ph < N_PHASES; ++ph) { p.ph_lo = ph; p.ph_hi = ph + 1; hipLaunchKernelGGL(fwd_kernel, dim3(grid), dim3(NTHREADS), LDS_BYTES, stream, p); }
#endif
}
```

```cpp
#include <hip/hip_runtime.h>
#include <hip/hip_cooperative_groups.h>
#include <cstdio>
#include <cstdint>
#include <cmath>
namespace cg = cooperative_groups;
#ifndef ONE_LAUNCH
#define ONE_LAUNCH 1
#endif
namespace pg8 {
#define PG8_LAS __attribute__((address_space(3)))
typedef unsigned short bf16_t;
typedef short bf16x8 __attribute__((ext_vector_type(8)));
typedef float f32x4 __attribute__((ext_vector_type(4)));
typedef unsigned u32x4 __attribute__((ext_vector_type(4)));
constexpr int BM = 256, BK = 64, HALF = 128, HTB = HALF * BK * 2  , STAGE_BYTES = 8 * HTB, NXCD = 8, WGM = 8;

__host__ __device__ __forceinline__ int lds_byte(int r, int c) { const int st = (r >> 4) * 2 + (c >> 5), rr = r & 15, cc = c & 31, ob = rr * 64 + cc * 2; return st * 1024 + (ob ^ (((ob >> 9) & 1) << 5)); }
__host__ __device__ __forceinline__ void stage_rc(int b, int& R, int& C) { const int st = b / 1024, sb = b % 1024, swz = sb ^ (((sb >> 9) & 1) << 5); R = (st >> 1) * 16 + swz / 64; C = (st & 1) * 32 + (swz % 64) / 2; }
__host__ __device__ __forceinline__ int perm32(int rho) { const int n = rho >> 4, i = rho & 15; return 8 * (i >> 2) + 4 * n + (i & 3); }

struct Unit { int pm, pn; };
struct Gemm { const bf16_t* A; const bf16_t* Bt; int M, N, K, lda, ldb, mtpg; size_t bgs; };

struct StaticOrder {
    int nM, nN, nwg, G, c;
    __host__ __device__ void init(int M, int N, int G_, int c_) { nM = M / BM; nN = N / BM; nwg = nM * nN; G = G_; c = c_; }
    __host__ __device__ bool next(int i, Unit& u) const {
        const long L = (long)i * G + c; if (L >= nwg) return false;
        int wgid = (int)L; { const int q = nwg / NXCD, r = nwg % NXCD, xcd = wgid % NXCD, off = wgid / NXCD; wgid = (xcd < r ? xcd * (q + 1) : r * (q + 1) + (xcd - r) * q) + off; }
        const int nig = WGM * nN, gid = wgid / nig, fm = gid * WGM, gsz = (nM - fm) < WGM ? (nM - fm) : WGM;
        u.pm = fm + ((wgid % nig) % gsz); u.pn = (wgid % nig) / gsz; return true;
    }
    __device__ __forceinline__ void a_ready(const Unit&) const {}
    __device__ __forceinline__ void done(const Unit&) const {}
};


constexpr float RMS_EPS = 1e-6f;
constexpr int TOK = 32768, DM = 1024, SEQL = 8192;
typedef float f32x2_t __attribute__((ext_vector_type(2))); typedef __bf16 bf16x2_t __attribute__((ext_vector_type(2)));
__device__ __forceinline__ unsigned cvt_pk_bf16(float lo, float hi) { const f32x2_t v = {lo, hi}; const bf16x2_t b = __builtin_convertvector(v, bf16x2_t); return __builtin_bit_cast(unsigned, b); }
__device__ __forceinline__ u32x4 pack8(const f32x4& a, const f32x4& b) { u32x4 w; w.x = cvt_pk_bf16(a[0], a[1]); w.y = cvt_pk_bf16(a[2], a[3]); w.z = cvt_pk_bf16(b[0], b[1]); w.w = cvt_pk_bf16(b[2], b[3]); return w; }
__device__ __forceinline__ float bf_lo(unsigned w) { return __uint_as_float(w << 16); }
__device__ __forceinline__ float bf_hi(unsigned w) { return __uint_as_float(w & 0xffff0000u); }
__device__ __forceinline__ void unpack8(const u32x4& w, f32x4& a, f32x4& b) { a = (f32x4){bf_lo(w.x), bf_hi(w.x), bf_lo(w.y), bf_hi(w.y)}; b = (f32x4){bf_lo(w.z), bf_hi(w.z), bf_lo(w.w), bf_hi(w.w)}; }
__device__ __forceinline__ float sigm(float x) { return __builtin_amdgcn_rcpf(1.f + __expf(-x)); }
__device__ __forceinline__ f32x4 sigm4(const f32x4& x) { return (f32x4){sigm(x[0]), sigm(x[1]), sigm(x[2]), sigm(x[3])}; }
__device__ __forceinline__ float row_rs(const float* ss, int row) { return ss ? __builtin_amdgcn_rsqf(ss[row] * (1.0f / 1024.0f) + RMS_EPS) : 1.0f; }

struct EpiSwiglu {
    static constexpr bool PERM = true, AFTER_DRAIN = false;
    bf16_t* O; int ldo; const float* ss;
    __device__ __forceinline__ void operator()(const f32x4 (&acc)[2][2][4][2], const Unit& u, int wr, int wc, int fr, int fq) const {
        const int col0 = u.pn * 128 + wc * 32 + 8 * fq;
#pragma unroll
        for (int ai = 0; ai < 2; ++ai)
#pragma unroll
            for (int m = 0; m < 4; ++m) {
                const int row = u.pm * BM + ai * HALF + wr * 64 + m * 16 + fr; const float rs = row_rs(ss, row);
                f32x4 o[2];
#pragma unroll
                for (int n = 0; n < 2; ++n) { const f32x4 g = acc[ai][0][m][n] * rs, up = acc[ai][1][m][n] * rs; o[n] = g * sigm4(g) * up; }
                *(u32x4*)(O + (size_t)row * ldo + col0) = pack8(o[0], o[1]);
            }
    }
};
struct EpiResid {
    static constexpr bool PERM = true, AFTER_DRAIN = false;
    const float* base; float* out; bf16_t* xb; float* ss; float alpha;
    __device__ __forceinline__ void operator()(const f32x4 (&acc)[2][2][4][2], const Unit& u, int wr, int wc, int fr, int fq) const {
        const int col0 = u.pn * BM + wc * 32 + 8 * fq;
#pragma unroll
        for (int ai = 0; ai < 2; ++ai)
#pragma unroll
            for (int m = 0; m < 4; ++m) {
                const int row = u.pm * BM + ai * HALF + wr * 64 + m * 16 + fr; float sq = 0.f;
#pragma unroll
                for (int bj = 0; bj < 2; ++bj) {
                    const size_t off = (size_t)row * DM + col0 + bj * HALF;
                    const f32x4 b0 = *(const f32x4*)(base + off), b1 = *(const f32x4*)(base + off + 4);
                    const f32x4 x0 = b0 + acc[ai][bj][m][0] * alpha, x1 = b1 + acc[ai][bj][m][1] * alpha;
                    *(f32x4*)(out + off) = x0; *(f32x4*)(out + off + 4) = x1;
                    if (xb) *(u32x4*)(xb + off) = pack8(x0, x1);
                    sq += (x0[0] * x0[0] + x0[1] * x0[1]) + (x0[2] * x0[2] + x0[3] * x0[3]) + (x1[0] * x1[0] + x1[1] * x1[1]) + (x1[2] * x1[2] + x1[3] * x1[3]);
                }
                if (ss) { sq += __shfl_xor(sq, 16); sq += __shfl_xor(sq, 32); if (fq == 0) unsafeAtomicAdd(ss + row, sq); }
                asm volatile("" ::: "memory");
            }
    }
};
struct EpiZ {
    static constexpr bool PERM = true, AFTER_DRAIN = false;
    bf16_t *Q, *K, *Vt, *U, *G; const float* ss; const float* gbias;
    __device__ __forceinline__ void operator()(const f32x4 (&acc)[2][2][4][2], const Unit& u, int wr, int wc, int fr, int fq) const {
        const int pn = u.pn;
#pragma unroll
        for (int ai = 0; ai < 2; ++ai)
#pragma unroll
            for (int m = 0; m < 4; ++m) {
                const int row = u.pm * BM + ai * HALF + wr * 64 + m * 16 + fr; const float rs = row_rs(ss, row);
                const int b = row >> 13, tt = row & (SEQL - 1);
#pragma unroll
                for (int bj = 0; bj < 2; ++bj) {
                    f32x4 z0 = acc[ai][bj][m][0] * rs, z1 = acc[ai][bj][m][1] * rs;
                    const int ct = bj * HALF + wc * 32 + 8 * fq;
                    if (pn < 9) {
                        const int seg = pn / 3, cs = (pn - seg * 3) * BM + ct, h = cs >> 6, dd0 = cs & 63, sh = 2 * (h >> 2);
                        const int tp = ((tt & ((1 << sh) - 1)) << (13 - sh)) + (tt >> sh);
                        const size_t bh = (size_t)(b * 12 + h);
                        if (seg == 0) { z0 = z0 * 0.125f; z1 = z1 * 0.125f; *(u32x4*)(Q + (bh * SEQL + tp) * 64 + dd0) = pack8(z0, z1); }
                        else if (seg == 1) { *(u32x4*)(K + (bh * SEQL + tp) * 64 + dd0) = pack8(z0, z1); }
                        else { const u32x4 w = pack8(z0, z1); bf16_t* vp = Vt + (bh * 64 + dd0) * SEQL + tp;
                            vp[0 * SEQL] = (bf16_t)(w.x & 0xffffu); vp[1 * SEQL] = (bf16_t)(w.x >> 16); vp[2 * SEQL] = (bf16_t)(w.y & 0xffffu); vp[3 * SEQL] = (bf16_t)(w.y >> 16);
                            vp[4 * SEQL] = (bf16_t)(w.z & 0xffffu); vp[5 * SEQL] = (bf16_t)(w.z >> 16); vp[6 * SEQL] = (bf16_t)(w.w & 0xffffu); vp[7 * SEQL] = (bf16_t)(w.w >> 16); }
                    } else if (pn < 11) {
                        const int cu = (pn - 9) * BM + ct, gg = cu >> 4;
                        *(u32x4*)(U + ((size_t)(gg * 1024 + b * 256 + (tt >> 5)) * 640 + (tt & 31) * 16 + (cu & 15))) = pack8(z0, z1);
                    } else {
                        const int cg_ = (pn - 11) * BM + ct;
                        const f32x4 g0 = *(const f32x4*)(gbias + cg_), g1 = *(const f32x4*)(gbias + cg_ + 4);
                        z0 = sigm4(z0 + g0); z1 = sigm4(z1 + g1);
                        *(u32x4*)(G + (size_t)row * 2048 + cg_) = pack8(z0, z1);
                    }
                }
            }
    }
};
struct EpiGateMul {
    static constexpr bool PERM = true, AFTER_DRAIN = false;
    bf16_t* O; const bf16_t* Gt;
    __device__ __forceinline__ void operator()(const f32x4 (&acc)[2][2][4][2], const Unit& u, int wr, int wc, int fr, int fq) const {
        const int col0 = u.pn * BM + wc * 32 + 8 * fq;
#pragma unroll
        for (int ai = 0; ai < 2; ++ai)
#pragma unroll
            for (int m = 0; m < 4; ++m) {
                const int row = u.pm * BM + ai * HALF + wr * 64 + m * 16 + fr;
#pragma unroll
                for (int bj = 0; bj < 2; ++bj) {
                    const int c = col0 + bj * HALF; f32x4 g0, g1; unpack8(*(const u32x4*)(Gt + (size_t)row * 2048 + c), g0, g1);
                    *(u32x4*)(O + (size_t)row * DM + c) = pack8(acc[ai][bj][m][0] * g0, acc[ai][bj][m][1] * g1);
                }
                asm volatile("" ::: "memory");
            }
    }
};
struct EpiGlu {
    static constexpr bool PERM = true, AFTER_DRAIN = false;
    bf16_t* O;
    __device__ __forceinline__ void operator()(const f32x4 (&acc)[2][2][4][2], const Unit& u, int wr, int wc, int fr, int fq) const {
        const int col0 = u.pn * 128 + wc * 32 + 8 * fq;
#pragma unroll
        for (int ai = 0; ai < 2; ++ai)
#pragma unroll
            for (int m = 0; m < 4; ++m) {
                const int row = u.pm * BM + ai * HALF + wr * 64 + m * 16 + fr;
                *(u32x4*)(O + (size_t)row * 512 + col0) = pack8(acc[ai][0][m][0] * sigm4(acc[ai][1][m][0]), acc[ai][0][m][1] * sigm4(acc[ai][1][m][1]));
            }
    }
};
struct EpiMerge {
    static constexpr bool PERM = true, AFTER_DRAIN = false;
    bf16_t* O; const bf16_t* M1; const bf16_t* Gt;
    __device__ __forceinline__ void operator()(const f32x4 (&acc)[2][2][4][2], const Unit& u, int wr, int wc, int fr, int fq) const {
        const int col0 = u.pn * BM + wc * 32 + 8 * fq;
#pragma unroll
        for (int ai = 0; ai < 2; ++ai)
#pragma unroll
            for (int m = 0; m < 4; ++m) {
                const int row = u.pm * BM + ai * HALF + wr * 64 + m * 16 + fr;
#pragma unroll
                for (int bj = 0; bj < 2; ++bj) {
                    const int c = col0 + bj * HALF; f32x4 g0, g1, a0, a1;
                    unpack8(*(const u32x4*)(Gt + (size_t)row * 2048 + c), g0, g1); unpack8(*(const u32x4*)(M1 + (size_t)row * DM + c), a0, a1);
                    *(u32x4*)(O + (size_t)row * DM + c) = pack8(a0 + acc[ai][bj][m][0] * g0, a1 + acc[ai][bj][m][1] * g1);
                }
                asm volatile("" ::: "memory");
            }
    }
};


struct EpiX {
    static constexpr bool PERM = true, AFTER_DRAIN = false;
    float* X;
    __device__ __forceinline__ void operator()(const f32x4 (&acc)[2][2][4][2], const Unit& u, int wr, int wc, int fr, int fq) const {
        const int col0 = wc * 32 + 8 * fq;
#pragma unroll
        for (int ai = 0; ai < 2; ++ai)
#pragma unroll
            for (int m = 0; m < 4; ++m) {
                const int row = u.pm * BM + ai * HALF + wr * 64 + m * 16 + fr;
                *(f32x4*)(X + (size_t)row * 128 + col0) = acc[ai][0][m][0]; *(f32x4*)(X + (size_t)row * 128 + col0 + 4) = acc[ai][0][m][1];
            }
    }
};
__device__ __forceinline__ float gelu_tanh_(float x) {
    const float u = 0.7978845608028654f * (x + 0.044715f * x * x * x);
    const float e = __expf(2.f * u);
    return 0.5f * x * (2.f - 2.f * __builtin_amdgcn_rcpf(e + 1.f));
}
__device__ __forceinline__ f32x4 gelu4(const f32x4& x) { return (f32x4){gelu_tanh_(x[0]), gelu_tanh_(x[1]), gelu_tanh_(x[2]), gelu_tanh_(x[3])}; }
struct EpiY {
    static constexpr bool PERM = true, AFTER_DRAIN = false;
    bf16_t* Y;
    __device__ __forceinline__ void operator()(const f32x4 (&acc)[2][2][4][2], const Unit& u, int wr, int wc, int fr, int fq) const {
#pragma unroll
        for (int ai = 0; ai < 2; ++ai)
#pragma unroll
            for (int m = 0; m < 4; ++m) {
                const int R = u.pm * BM + ai * HALF + wr * 64 + m * 16 + fr, gg = R >> 10, b = (R >> 8) & 3, k = R & 255;
#pragma unroll
                for (int bj = 0; bj < 2; ++bj) {
                    const int c = u.pn * BM + bj * HALF + wc * 32 + 8 * fq, i = c >> 4;
                    *(u32x4*)(Y + (size_t)(b * SEQL + 32 * k + i) * 512 + 16 * gg + (c & 15)) = pack8(gelu4(acc[ai][bj][m][0]), gelu4(acc[ai][bj][m][1]));
                }
            }
    }
};
template <class Epi, class Sched, bool ALIGN_EPI = false, bool SP2 = false>
__device__ __forceinline__ void gemm_phase(PG8_LAS unsigned char* lds, const Gemm g, const Sched& S, const Epi& E) {
    int tid_ = threadIdx.x; asm volatile("" : "+v"(tid_) :: "memory");
    const int tid = tid_, wid = __builtin_amdgcn_readfirstlane(tid >> 6), lane = tid & 63, wr = wid >> 2, wc = wid & 3, fr = lane & 15, fq = lane >> 4;
    const int K = g.K, nt = K / BK;
    unsigned voffA[2], voffB[2];
#pragma unroll
    for (int i = 0; i < 2; ++i) { int R, C; stage_rc(tid * 16 + i * 8192, R, C); const int Rb = Epi::PERM ? ((R & ~31) + perm32(R & 31)) : R;
        voffA[i] = (unsigned)(R * g.lda + C) * 2u; voffB[i] = (unsigned)(Rb * g.ldb + C) * 2u; }
    const size_t kstep = (size_t)(BK * 2);
    const size_t hstepA = (size_t)HALF * g.lda * 2, hstepB = (size_t)HALF * g.ldb * 2;
    const size_t tstepA = 2 * hstepA, tstepB = 2 * hstepB;
    const unsigned ldsw = (unsigned)wid * 1024u;
    const int aoff = lds_byte(wr * 64 + fr, fq * 8), boff = lds_byte(wc * 32 + fr, fq * 8);
#define PG8_SA(b, h) (((b) * 2 + (h)) * HTB)
#define PG8_SB(b, h) ((4 + (b) * 2 + (h)) * HTB)
#define PG8_STAGE(bufoff, gbase, voff) do { _Pragma("unroll") for (int _i = 0; _i < 2; ++_i) \
        __builtin_amdgcn_global_load_lds((const unsigned*)((const char*)(gbase) + (voff)[_i]), (PG8_LAS unsigned*)(lds + (bufoff) + ldsw + _i * 8192), 16, 0, 0); } while (0)
#define PG8_LDA(dst, b, h) do { _Pragma("unroll") for (int m = 0; m < 4; ++m) _Pragma("unroll") for (int k = 0; k < 2; ++k) dst[m][k] = *(const PG8_LAS bf16x8*)(lds + PG8_SA(b, h) + aoff + m * 2048 + k * 1024); } while (0)
#define PG8_LDB(dst, b, h) do { _Pragma("unroll") for (int n = 0; n < 2; ++n) _Pragma("unroll") for (int k = 0; k < 2; ++k) dst[n][k] = *(const PG8_LAS bf16x8*)(lds + PG8_SB(b, h) + boff + n * 2048 + k * 1024); } while (0)
#define PG8_MMA(ai, bj, At, Bt) do { __builtin_amdgcn_s_setprio(1); _Pragma("unroll") for (int m = 0; m < 4; ++m) _Pragma("unroll") for (int n = 0; n < 2; ++n) _Pragma("unroll") for (int k = 0; k < 2; ++k) \
        acc[ai][bj][m][n] = __builtin_amdgcn_mfma_f32_16x16x32_bf16(Bt[n][k], At[m][k], acc[ai][bj][m][n], 0, 0, 0); __builtin_amdgcn_s_setprio(0); } while (0)
#define PG8_WAIT_V(n) asm volatile("s_waitcnt vmcnt(" #n ")" ::: "memory")
#define PG8_WAIT_L(n) asm volatile("s_waitcnt lgkmcnt(" #n ")" ::: "memory")
#define PG8_BAR __builtin_amdgcn_s_barrier()
#define PG8_SCHED __builtin_amdgcn_sched_barrier(0)
    Unit cur, nxt; int ui = 0;
    if (!S.next(0, cur)) return;
    f32x4 acc[2][2][4][2];
#pragma unroll
    for (int a = 0; a < 2; ++a)
#pragma unroll
        for (int b = 0; b < 2; ++b)
#pragma unroll
            for (int m = 0; m < 4; ++m)
#pragma unroll
                for (int n = 0; n < 2; ++n) acc[a][b][m][n] = (f32x4){0.f, 0.f, 0.f, 0.f};
    bf16x8 At[4][2], B0[2][2], B1[2][2];
    const char* cA = (const char*)g.A + (size_t)cur.pm * tstepA; const char* cB = (const char*)g.Bt + (size_t)cur.pn * tstepB + (size_t)(cur.pm / g.mtpg) * g.bgs;
    S.a_ready(cur);
    if constexpr (SP2) {
        PG8_STAGE(PG8_SB(0, 0), cB, voffB); PG8_STAGE(PG8_SB(0, 1), cB + hstepB, voffB); PG8_STAGE(PG8_SA(0, 0), cA, voffA); PG8_STAGE(PG8_SA(0, 1), cA + hstepA, voffA);
        if (wr == 1) PG8_BAR;
        PG8_WAIT_V(2); PG8_BAR;
        PG8_STAGE(PG8_SB(1, 0), cB + kstep, voffB); PG8_STAGE(PG8_SA(1, 0), cA + kstep, voffA); PG8_STAGE(PG8_SB(1, 1), cB + hstepB + kstep, voffB);
        PG8_WAIT_V(6); PG8_BAR;
    } else {
        PG8_STAGE(PG8_SB(0, 0), cB, voffB); PG8_STAGE(PG8_SA(0, 0), cA, voffA); PG8_STAGE(PG8_SB(0, 1), cB + hstepB, voffB); PG8_STAGE(PG8_SA(0, 1), cA + hstepA, voffA);
        if (wr == 1) PG8_BAR;
        PG8_WAIT_V(4); PG8_BAR;
        PG8_STAGE(PG8_SB(1, 0), cB + kstep, voffB); PG8_STAGE(PG8_SA(1, 0), cA + kstep, voffA); PG8_STAGE(PG8_SB(1, 1), cB + hstepB + kstep, voffB);
        PG8_WAIT_V(6); PG8_BAR;
    }
    for (;;) {
        const bool has_next = S.next(ui + 1, nxt);
        const char* nA = has_next ? (const char*)g.A + (size_t)nxt.pm * tstepA : cA; const char* nB = has_next ? (const char*)g.Bt + (size_t)nxt.pn * tstepB + (size_t)(nxt.pm / g.mtpg) * g.bgs : cB;
#pragma unroll 1
        for (int t = 0; t < nt; t += 2) {
            const bool last = (t == nt - 2);
            const char* a1 = cA + (size_t)(t + 1) * kstep;
            const char* a2 = last ? nA : cA + (size_t)(t + 2) * kstep; const char* b2 = last ? nB : cB + (size_t)(t + 2) * kstep;
            const char* a3 = a2 + kstep; const char* b3 = b2 + kstep;
            if (last && has_next) S.a_ready(nxt);
            if constexpr (SP2) {
            PG8_LDB(B0, 0, 0); PG8_LDB(B1, 0, 1); PG8_SCHED; PG8_LDA(At, 0, 0); PG8_STAGE(PG8_SA(1, 1), a1 + hstepA, voffA);
            PG8_WAIT_V(8); PG8_WAIT_L(0); PG8_BAR; PG8_MMA(0, 0, At, B0); PG8_MMA(0, 1, At, B1); PG8_BAR; PG8_SCHED;
            PG8_LDA(At, 0, 1); PG8_STAGE(PG8_SB(0, 0), b2, voffB); PG8_STAGE(PG8_SB(0, 1), b2 + hstepB, voffB); PG8_STAGE(PG8_SA(0, 0), a2, voffA);
            PG8_WAIT_V(8); PG8_WAIT_L(0); PG8_BAR; PG8_MMA(1, 0, At, B0); PG8_MMA(1, 1, At, B1); PG8_BAR; PG8_SCHED;
            PG8_LDB(B0, 1, 0); PG8_LDB(B1, 1, 1); PG8_SCHED; PG8_LDA(At, 1, 0); PG8_STAGE(PG8_SA(0, 1), a2 + hstepA, voffA);
            PG8_WAIT_V(8); PG8_WAIT_L(0); PG8_BAR; PG8_MMA(0, 0, At, B0); PG8_MMA(0, 1, At, B1); PG8_BAR; PG8_SCHED;
            PG8_LDA(At, 1, 1); PG8_STAGE(PG8_SB(1, 0), b3, voffB); PG8_STAGE(PG8_SB(1, 1), b3 + hstepB, voffB); PG8_STAGE(PG8_SA(1, 0), a3, voffA);
            PG8_WAIT_V(8); PG8_WAIT_L(0); PG8_BAR; PG8_MMA(1, 0, At, B0); PG8_MMA(1, 1, At, B1); PG8_BAR; PG8_SCHED;
            } else {
            PG8_LDB(B0, 0, 0); PG8_SCHED; PG8_LDA(At, 0, 0); PG8_STAGE(PG8_SA(1, 1), a1 + hstepA, voffA);
            PG8_WAIT_L(8); PG8_BAR; PG8_WAIT_L(0); PG8_MMA(0, 0, At, B0); PG8_BAR; PG8_SCHED;
            PG8_LDB(B1, 0, 1); PG8_STAGE(PG8_SB(0, 0), b2, voffB);
            PG8_BAR; PG8_WAIT_L(0); PG8_MMA(0, 1, At, B1); PG8_BAR;
            PG8_LDA(At, 0, 1); PG8_STAGE(PG8_SA(0, 0), a2, voffA);
            PG8_BAR; PG8_WAIT_L(0); PG8_MMA(1, 0, At, B0); PG8_BAR; PG8_SCHED;
            PG8_STAGE(PG8_SB(0, 1), b2 + hstepB, voffB);
            PG8_WAIT_V(6); PG8_BAR; PG8_MMA(1, 1, At, B1); PG8_BAR;
            PG8_LDB(B0, 1, 0); PG8_SCHED; PG8_LDA(At, 1, 0); PG8_STAGE(PG8_SA(0, 1), a2 + hstepA, voffA);
            PG8_WAIT_L(8); PG8_BAR; PG8_WAIT_L(0); PG8_MMA(0, 0, At, B0); PG8_BAR; PG8_SCHED;
            PG8_LDB(B1, 1, 1); PG8_STAGE(PG8_SB(1, 0), b3, voffB);
            PG8_BAR; PG8_WAIT_L(0); PG8_MMA(0, 1, At, B1); PG8_BAR;
            PG8_LDA(At, 1, 1); PG8_STAGE(PG8_SA(1, 0), a3, voffA);
            PG8_BAR; PG8_WAIT_L(0); PG8_MMA(1, 0, At, B0); PG8_BAR; PG8_SCHED;
            PG8_STAGE(PG8_SB(1, 1), b3 + hstepB, voffB);
            PG8_WAIT_V(6); PG8_BAR; PG8_MMA(1, 1, At, B1); PG8_BAR;
            }
        }
        if constexpr (ALIGN_EPI) { if (wr == 0) PG8_BAR; }
        if constexpr (!Epi::AFTER_DRAIN) { E(acc, cur, wr, wc, fr, fq); S.done(cur); }
        if (!has_next) break;
#pragma unroll
        for (int a = 0; a < 2; ++a)
#pragma unroll
            for (int b = 0; b < 2; ++b)
#pragma unroll
                for (int m = 0; m < 4; ++m)
#pragma unroll
                    for (int n = 0; n < 2; ++n) acc[a][b][m][n] = (f32x4){0.f, 0.f, 0.f, 0.f};
        cur = nxt; cA = nA; cB = nB; ++ui;
        if constexpr (ALIGN_EPI) { if (wr == 1) PG8_BAR; }
    }
    PG8_WAIT_V(0);
    if constexpr (!ALIGN_EPI) { if (wr == 0) PG8_BAR; }
    PG8_BAR;
    if constexpr (Epi::AFTER_DRAIN) { E.fused(acc, cur, wr, wc, fr, fq, lds, wid, lane); S.done(cur); }
#undef PG8_SA
#undef PG8_SB
#undef PG8_STAGE
#undef PG8_LDA
#undef PG8_LDB
#undef PG8_MMA
#undef PG8_WAIT_V
#undef PG8_WAIT_L
#undef PG8_BAR
#undef PG8_SCHED
}
}

using pg8::bf16_t; using pg8::bf16x8; using pg8::f32x4; using pg8::u32x4;
typedef float f32x2 __attribute__((ext_vector_type(2)));
typedef unsigned u32x2 __attribute__((ext_vector_type(2)));
#define LAS __attribute__((address_space(3)))
constexpr int NWAVES = 8, NTHREADS = 512;
constexpr int T = 32768, D = 1024, L = 8192, NB = 4, FF = 2816, INW = 4864, NH = 12;
constexpr float EPS = 1e-6f;
constexpr int LDS_BYTES = 147456;
constexpr int N_PHASES = 13;

constexpr size_t MiB = 1u << 20, KiB = 1u << 10;
constexpr size_t WS_SS1 = 0, WS_SS2 = 128 * KiB, WS_SS3 = 256 * KiB, WS_SSD = 384 * KiB;
constexpr size_t WS_BBAR = 576 * KiB;
constexpr size_t WS_LUT = 832 * KiB;
constexpr size_t WS_BAR = 848 * KiB;
constexpr size_t WS_APOW = 896 * KiB;
constexpr size_t WS_WGU1 = 2 * MiB, WS_WD1 = 13 * MiB, WS_WIN = WS_WD1 + 5632 * KiB, WS_WA = WS_WIN + 9728 * KiB, WS_WGLU = WS_WA + 512 * KiB,
                 WS_WS = WS_WGLU + 1 * MiB, WS_WOUT = WS_WS + 1 * MiB, WS_WGU2 = WS_WOUT + 2 * MiB, WS_WD2 = WS_WGU2 + 11 * MiB, WS_WEND = WS_WD2 + 5632 * KiB;
static_assert(WS_WEND <= 50 * MiB && WS_APOW + 32 * 64 * 66 * 4 <= 2 * MiB, "weights / control region");
constexpr size_t WS_XB = 50 * MiB;
constexpr size_t WS_OC = WS_XB, WS_YG = WS_XB + 16 * MiB, WS_X = WS_XB + 48 * MiB;
constexpr size_t WS_RA = 114 * MiB;
constexpr size_t WS_A1 = WS_RA, WS_Q = WS_RA, WS_K = WS_RA + 48 * MiB, WS_VT = WS_RA + 96 * MiB, WS_BTX = WS_RA + 144 * MiB, WS_BTY = WS_RA + 152 * MiB;
constexpr size_t WS_M1 = WS_RA, WS_YS = WS_RA + 64 * MiB, WS_MG = WS_RA + 96 * MiB;
constexpr size_t WS_G = 290 * MiB;
constexpr size_t WS_OG = 418 * MiB, WS_LSE = 466 * MiB, WS_AY = 468 * MiB, WS_END = 508 * MiB;
constexpr int CN = 32, AYP = 640;
constexpr size_t BAR_ZERO_BYTES = 16 * KiB;
#define XB_TMO      128
#define XB_XCNT(j)  (256  + 64 * (j))
#define XB_XSUB(j)  (1280 + 64 * (j))
#define XB_XGEN(j)  (2304 + 64 * (j))
#define XB_TOP      3328
#define XB_TOPGEN   3392
#define XCD_BAR_WORDS 3456
#define XB_SPIN_CAP (1u << 18)

__device__ __forceinline__ unsigned xb_ld(unsigned* p)              { return __hip_atomic_load(p, __ATOMIC_RELAXED, __HIP_MEMORY_SCOPE_AGENT); }
__device__ __forceinline__ unsigned xb_add(unsigned* p, unsigned v) { return __hip_atomic_fetch_add(p, v, __ATOMIC_RELAXED, __HIP_MEMORY_SCOPE_AGENT); }
__device__ __forceinline__ unsigned xb_xcc_id() { return (unsigned)__builtin_amdgcn_s_getreg((3 << 11) | 20) & 0xFu; }
#define XB_SPIN(cond, bar) do { unsigned _sp = 0; while (cond) { __builtin_amdgcn_s_sleep(1); \
    if ((++_sp & 255u) == 0u) { if (xb_ld(&(bar)[XB_TMO])) break; if (_sp > XB_SPIN_CAP) { atomicAdd(&(bar)[XB_TMO], 1u); break; } } } } while (0)

struct XcdBarrier {
    unsigned* bar; unsigned x;
    volatile LAS unsigned* st;
};

__device__ __forceinline__ XcdBarrier xcd_barrier_post(unsigned* bar, volatile LAS unsigned* st) {
    XcdBarrier b; b.bar = bar; b.x = xb_xcc_id(); b.st = st;
    if (threadIdx.x == 0) (void)xb_add(&bar[XB_XCNT(b.x)], 1u);
    return b;
}
__device__ __forceinline__ void xcd_barrier_complete(unsigned* bar, unsigned x, unsigned& nloc, unsigned& nx) {
    const unsigned G = gridDim.x * gridDim.y * gridDim.z;
    unsigned sum, cnt, mine, sp = 0u;
    for (;;) {
        sum = 0u; cnt = 0u; mine = 0u;
#pragma unroll
        for (unsigned j = 0; j < 16; ++j) { const unsigned c = xb_ld(&bar[XB_XCNT(j)]); sum += c; cnt += (c > 0u) ? 1u : 0u; mine = (j == x) ? c : mine; }
        if (sum == G) break;
        __builtin_amdgcn_s_sleep(1);
        if ((++sp & 255u) == 0u) { if (xb_ld(&bar[XB_TMO])) break; if (sp > XB_SPIN_CAP) { atomicAdd(&bar[XB_TMO], 1u); break; } }
    }
    nloc = mine > 0u ? mine : 1u; nx = cnt > 0u ? cnt : 1u;
}

__device__ __forceinline__ void xcd_barrier(const XcdBarrier& b) {
    asm volatile("s_waitcnt vmcnt(0)" ::: "memory");
    __syncthreads();
    if (threadIdx.x == 0) {
        unsigned* bar = b.bar;
        __builtin_amdgcn_s_waitcnt(0);
        unsigned nloc = b.st[0], nx = b.st[1];
        if (nloc == 0u) { xcd_barrier_complete(bar, b.x, nloc, nx); b.st[0] = nloc; b.st[1] = nx; }
        const unsigned old = xb_add(&bar[XB_XSUB(b.x)], 1u);
        const unsigned gen = old / nloc;
        if (old + 1u == (gen + 1u) * nloc) {
            __builtin_amdgcn_fence(__ATOMIC_RELEASE, "agent");
            asm volatile("s_waitcnt vmcnt(0)" ::: "memory");
            const unsigned og = xb_add(&bar[XB_TOP], 1u);
            const unsigned tg = og / nx;
            if (og + 1u == (tg + 1u) * nx) xb_add(&bar[XB_TOPGEN], 1u);
            else XB_SPIN(xb_ld(&bar[XB_TOPGEN]) == tg, bar);
            __builtin_amdgcn_fence(__ATOMIC_ACQUIRE, "agent");
            xb_add(&bar[XB_XGEN(b.x)], 1u);
            asm volatile("s_waitcnt vmcnt(0)" ::: "memory");
        } else {
            XB_SPIN(xb_ld(&bar[XB_XGEN(b.x)]) == gen, bar);
            __builtin_amdgcn_fence(__ATOMIC_ACQUIRE, "agent");
            asm volatile("s_waitcnt vmcnt(0)" ::: "memory");
        }
    }
    __syncthreads();
}

struct Params { const float* in[26]; float* out; unsigned char* ws; int ph_lo, ph_hi; unsigned char bk[3][136]; };

__device__ __forceinline__ float wave_sum(float v) {
#pragma unroll
    for (int o = 1; o < 64; o <<= 1) v += __shfl_xor(v, o);
    return v;
}
__device__ __forceinline__ unsigned f2bf(float f) { unsigned u = __builtin_bit_cast(unsigned, f); return (u + 0x7fffu + ((u >> 16) & 1u)) >> 16; }
__device__ __forceinline__ unsigned pk2(float lo, float hi) { return f2bf(lo) | (f2bf(hi) << 16); }
#define LDS_WAIT() asm volatile("s_waitcnt lgkmcnt(0)" ::: "memory")

__device__ __forceinline__ void transpose_item(const float* W, int K, int N, bf16_t* WT, int k0, int n0, int rowbase, const float* gain, LAS float* scr, int lane) {
#pragma unroll 8
    for (int i = 0; i < 32; ++i) { const int kk = 2 * i + (lane >> 5); float v = W[(size_t)(k0 + kk) * N + n0 + (lane & 31)]; if (gain) v *= gain[k0 + kk]; scr[kk * 33 + (lane & 31)] = v; }
    LDS_WAIT();
    const int c = lane & 7;
#pragma unroll
    for (int j = 0; j < 4; ++j) { const int n = (lane >> 3) + 8 * j; const LAS float* s = scr + (8 * c) * 33 + n;
        u32x4 o; o.x = pk2(s[0 * 33], s[1 * 33]); o.y = pk2(s[2 * 33], s[3 * 33]); o.z = pk2(s[4 * 33], s[5 * 33]); o.w = pk2(s[6 * 33], s[7 * 33]);
        *(u32x4*)(WT + (size_t)(rowbase + n) * K + k0 + 8 * c) = o; }
    LDS_WAIT();
}
__device__ __forceinline__ int tdesc_row(int mode, int N, int n0) {
    if (mode == 0) return n0;
    if (mode == 1) return (n0 >> 7) * 256 + (n0 & 127);
    if (mode == 2) return (n0 >> 7) * 256 + 128 + (n0 & 127);
    const int half = N >> 1; const int j = n0 < half ? n0 : n0 - half; return (j >> 7) * 256 + (n0 < half ? 0 : 128) + (j & 127);
}

__device__ __forceinline__ float gelu_tanh(float x) {
    const float u = 0.7978845608028654f * (x + 0.044715f * x * x * x);
    const float e = __expf(2.f * u);
    const float th = 1.f - 2.f * __builtin_amdgcn_rcpf(e + 1.f);
    return 0.5f * x * (1.f + th);
}

__device__ __forceinline__ pg8::Gemm mk_gemm(const bf16_t* A, const bf16_t* Bt, int M, int N, int K) { return pg8::Gemm{A, Bt, M, N, K, K, K, 1 << 30, (size_t)0}; }

__global__ void __launch_bounds__(NTHREADS, 2) fwd_kernel(Params P) {
    extern __shared__ __attribute__((aligned(16))) unsigned char lds_raw[];
    LAS unsigned char* lds = (LAS unsigned char*)lds_raw;
    const int tid = threadIdx.x, lane = tid & 63, wave = __builtin_amdgcn_readfirstlane(tid >> 6);
    const int G = gridDim.x, bid = blockIdx.x;
    const int gw = bid * NWAVES + wave, NGW = G * NWAVES;
    unsigned char* ws = P.ws;
    float* ss1 = (float*)(ws + WS_SS1); float* ss2 = (float*)(ws + WS_SS2); float* ss3 = (float*)(ws + WS_SS3);
    float* bbar = (float*)(ws + WS_BBAR); float* lutg = (float*)(ws + WS_LUT); float* apow = (float*)(ws + WS_APOW);
    bf16_t* Wgu1 = (bf16_t*)(ws + WS_WGU1); bf16_t* Wd1 = (bf16_t*)(ws + WS_WD1); bf16_t* Win = (bf16_t*)(ws + WS_WIN); bf16_t* Wa = (bf16_t*)(ws + WS_WA);
    bf16_t* Wglu = (bf16_t*)(ws + WS_WGLU); bf16_t* Wsb = (bf16_t*)(ws + WS_WS); bf16_t* Wout = (bf16_t*)(ws + WS_WOUT); bf16_t* Wgu2 = (bf16_t*)(ws + WS_WGU2); bf16_t* Wd2 = (bf16_t*)(ws + WS_WD2);
    bf16_t* XB = (bf16_t*)(ws + WS_XB); bf16_t* Oc = (bf16_t*)(ws + WS_OC); bf16_t* Yg = (bf16_t*)(ws + WS_YG); float* Xs = (float*)(ws + WS_X);
    bf16_t* A1 = (bf16_t*)(ws + WS_A1); bf16_t* Qp = (bf16_t*)(ws + WS_Q); bf16_t* Kp = (bf16_t*)(ws + WS_K); bf16_t* Vtp = (bf16_t*)(ws + WS_VT);
    bf16_t* BtX = (bf16_t*)(ws + WS_BTX); bf16_t* BtY = (bf16_t*)(ws + WS_BTY); bf16_t* AY = (bf16_t*)(ws + WS_AY);
    bf16_t* M1 = (bf16_t*)(ws + WS_M1); bf16_t* Ys = (bf16_t*)(ws + WS_YS); bf16_t* MG = (bf16_t*)(ws + WS_MG);
    bf16_t* Gt = (bf16_t*)(ws + WS_G); bf16_t* Og = (bf16_t*)(ws + WS_OG); float* LSE = (float*)(ws + WS_LSE);
    const float* x = P.in[0];
    float* dumF = (float*)(ws + WS_G); bf16_t* dumB = (bf16_t*)(ws + WS_M1); float* ssd = (float*)(ws + WS_SSD);
    float* out = P.out;
    const int lo = P.ph_lo, hi = P.ph_hi;
    volatile LAS unsigned* misc = (volatile LAS unsigned*)(lds + 131072 + 64);
    if (tid < 2) misc[tid] = 0u;
    __syncthreads();
    XcdBarrier bar; bar.bar = (unsigned*)(ws + WS_BAR); bar.x = 0; bar.st = nullptr;
    if (hi - lo > 1) bar = xcd_barrier_post((unsigned*)(ws + WS_BAR), misc);
#ifndef REPEAT_PH
#define REPEAT_PH (-1)
#endif
#ifndef REPEAT_N
#define REPEAT_N 1
#endif
#define REPS(k) (((k) == REPEAT_PH) ? 1 + REPEAT_N : 1)
#ifndef PHMASK
#define PHMASK 0xFFFF
#endif
#define IN_PH(k) ((((PHMASK) >> (k)) & 1) && lo <= (k) && (k) < hi)
#define SEAM(k) do { if (IN_PH(k) && IN_PH((k) + 1)) { if ((k) == 0) cg::this_grid().sync(); else xcd_barrier(bar); } } while (0)

    if (IN_PH(0)) for (int rep = 0; rep < REPS(0); ++rep) {
        LAS float* scr = (LAS float*)(lds + wave * 16384);
        int itbase = 0;
#define DO_MAT(Wp, Kd, Nd, WTp, MODE, GAIN) do { const int nblk = (Nd) / 32, nit = ((Kd) / 64) * nblk; const int first = (gw - (itbase % NGW) + NGW) % NGW; \
            for (int it = first; it < nit; it += NGW) { const int kb = it / nblk, nb = it % nblk; transpose_item((Wp), (Kd), (Nd), (WTp), 64 * kb, 32 * nb, tdesc_row((MODE), (Nd), 32 * nb), (GAIN), scr, lane); } \
            itbase += nit; } while (0)
        DO_MAT(P.in[2], D, FF, Wgu1, 1, (const float*)nullptr); DO_MAT(P.in[3], D, FF, Wgu1, 2, (const float*)nullptr); DO_MAT(P.in[4], FF, D, Wd1, 0, (const float*)nullptr);
        DO_MAT(P.in[6], D, INW, Win, 0, P.in[5]); DO_MAT(P.in[18], 256, D, Wa, 0, (const float*)nullptr); DO_MAT(P.in[17], 512, D, Wglu, 3, (const float*)nullptr);
        DO_MAT(P.in[19], 512, D, Wsb, 0, (const float*)nullptr); DO_MAT(P.in[20], D, D, Wout, 0, (const float*)nullptr);
        DO_MAT(P.in[22], D, FF, Wgu2, 1, P.in[21]); DO_MAT(P.in[23], D, FF, Wgu2, 2, P.in[21]); DO_MAT(P.in[24], FF, D, Wd2, 0, (const float*)nullptr);
#undef DO_MAT
        { const float* g1 = P.in[1];
          for (int r = gw; r < T; r += NGW) {
            const f32x4* xr = (const f32x4*)(x + (size_t)r * D) + lane; f32x4 v[4]; float s = 0.f;
#pragma unroll
            for (int j = 0; j < 4; ++j) { v[j] = xr[64 * j]; s += (v[j][0] * v[j][0] + v[j][1] * v[j][1]) + (v[j][2] * v[j][2] + v[j][3] * v[j][3]); }
            const float rinv = 1.0f / sqrtf(wave_sum(s) * (1.0f / D) + EPS);
            u32x2* o8 = (u32x2*)(XB + (size_t)r * D) + lane;
#pragma unroll
            for (int j = 0; j < 4; ++j) { const f32x4 gg = ((const f32x4*)g1)[lane + 64 * j]; u32x2 w; w.x = pk2(v[j][0] * rinv * gg[0], v[j][1] * rinv * gg[1]); w.y = pk2(v[j][2] * rinv * gg[2], v[j][3] * rinv * gg[3]); o8[64 * j] = w; }
          } }
        for (int i = bid * NTHREADS + tid; i < 3 * T; i += G * NTHREADS) ((float*)(ws + WS_SS1))[i] = 0.f;
        for (int i = bid * NTHREADS + tid; i < 32 * 64; i += G * NTHREADS) {
            const int g = i >> 6;
            const float dt = expf(P.in[11][g]), lre = P.in[9][i], lim = P.in[10][i];
            const float zr = lre * dt, zi = lim * dt, em1 = expm1f(zr), mag = em1 + 1.0f, cz = cosf(zi), sz = sinf(zi), sh = sinf(0.5f * zi);
            const float abim = mag * sz;
            const float xr = em1 * cz - 2.0f * sh * sh;
            const float den = lre * lre + lim * lim;
            const float cre = (xr * lre + abim * lim) / den, cim = (abim * lre - xr * lim) / den;
            for (int p = 0; p <= 32; ++p) { const float mp = expf(zr * (float)p), ang = zi * (float)p; apow[(size_t)i * 66 + 2 * p] = mp * cosf(ang); apow[(size_t)i * 66 + 2 * p + 1] = mp * sinf(ang); }
            for (int c = 0; c < 16; ++c) { const float br = P.in[12][i * 16 + c], bi = P.in[13][i * 16 + c];
                bbar[i * 32 + c] = cre * br - cim * bi; bbar[i * 32 + 16 + c] = cre * bi + cim * br; }
        }
        for (int i = bid * NTHREADS + tid; i < 12 * 132; i += G * NTHREADS) { const int h = i / 132, s = i % 132; lutg[i] = (s <= 128) ? P.in[8][(int)P.bk[h >> 2][s] * 12 + h] : 0.f; }
    }
    SEAM(0);

    if (IN_PH(1)) for (int rep = 0; rep < REPS(1); ++rep) {
        const pg8::Gemm g = mk_gemm(XB, Wgu1, T, 2 * FF, D); pg8::StaticOrder S; S.init(T, 2 * FF, G, bid);
        pg8::EpiSwiglu E{A1, FF, nullptr};
        pg8::gemm_phase<pg8::EpiSwiglu, pg8::StaticOrder, true, true>(lds, g, S, E);
    }
    SEAM(1);
    if (IN_PH(2)) for (int rep = 0; rep < REPS(2); ++rep) {
        const pg8::Gemm g = mk_gemm(A1, Wd1, T, D, FF); pg8::StaticOrder S; S.init(T, D, G, bid);
        pg8::EpiResid E{x, rep ? dumF : out, XB, rep ? ssd : ss1, 0.5f};
        pg8::gemm_phase<pg8::EpiResid, pg8::StaticOrder, true, true>(lds, g, S, E);
    }
    SEAM(2);
    if (IN_PH(3)) for (int rep = 0; rep < REPS(3); ++rep) {
        const float* cre_g = P.in[14]; const float* cim_g = P.in[15]; const float* dsk = P.in[16];
        for (int i = bid * NTHREADS + tid; i < 32 * 64 * 32; i += G * NTHREADS) {
            const int ip = i & 31, gn = i >> 5, g = gn >> 6, n = gn & 63;
            const float wr_ = apow[(size_t)gn * 66 + 2 * (31 - ip)], wi_ = apow[(size_t)gn * 66 + 2 * (31 - ip) + 1];
            f32x4 br[4], bi[4];
#pragma unroll
            for (int q = 0; q < 4; ++q) { br[q] = *(const f32x4*)(bbar + gn * 32 + 4 * q); bi[q] = *(const f32x4*)(bbar + gn * 32 + 16 + 4 * q); }
            bf16_t* r0 = BtX + ((size_t)(g * 256 + 2 * n) * 512 + ip * 16);
            *(u32x4*)(r0) = pg8::pack8(br[0] * wr_ - bi[0] * wi_, br[1] * wr_ - bi[1] * wi_); *(u32x4*)(r0 + 8) = pg8::pack8(br[2] * wr_ - bi[2] * wi_, br[3] * wr_ - bi[3] * wi_);
            *(u32x4*)(r0 + 512) = pg8::pack8(bi[0] * wr_ + br[0] * wi_, bi[1] * wr_ + br[1] * wi_); *(u32x4*)(r0 + 512 + 8) = pg8::pack8(bi[2] * wr_ + br[2] * wi_, bi[3] * wr_ + br[3] * wi_);
        }
        for (int i = bid * NTHREADS + tid; i < 32 * 128 * 64; i += G * NTHREADS) { const int g = i >> 13, r = (i >> 6) & 127, c8 = i & 63; *(u32x4*)(BtX + ((size_t)(g * 256 + 128 + r) * 512 + c8 * 8)) = (u32x4){0u, 0u, 0u, 0u}; }
        for (int i = bid * NTHREADS + tid; i < 32 * 512 * 64; i += G * NTHREADS) {
            const int n = i & 63, row = (i >> 6) & 511, g = i >> 15, ii = row >> 4, co = row & 15;
            const float wr_ = apow[(size_t)(g * 64 + n) * 66 + 2 * (ii + 1)], wi_ = apow[(size_t)(g * 64 + n) * 66 + 2 * (ii + 1) + 1];
            const float cr = cre_g[(g * 16 + co) * 64 + n], ci = cim_g[(g * 16 + co) * 64 + n];
            *(unsigned*)(BtY + ((size_t)(g * 512 + row) * AYP + 512 + 2 * n)) = pg8::cvt_pk_bf16(cr * wr_ - ci * wi_, -(cr * wi_ + ci * wr_));
        }
        for (int it = gw; it < 32 * 63; it += NGW) {
            const int g = it / 63, tau = it - g * 63 - 31, ci = lane & 15, coq = lane >> 4;
            float kv[4] = {0.f, 0.f, 0.f, 0.f};
            if (tau >= 0) {
#pragma unroll 4
                for (int n = 0; n < 64; ++n) {
                    const int gn = g * 64 + n;
                    const float wr_ = apow[(size_t)gn * 66 + 2 * tau], wi_ = apow[(size_t)gn * 66 + 2 * tau + 1];
                    const float br = bbar[gn * 32 + ci], bi = bbar[gn * 32 + 16 + ci];
                    const float tr = wr_ * br - wi_ * bi, ti = wr_ * bi + wi_ * br;
#pragma unroll
                    for (int j = 0; j < 4; ++j) { const int co = coq + 4 * j; kv[j] += cre_g[(g * 16 + co) * 64 + n] * tr - cim_g[(g * 16 + co) * 64 + n] * ti; }
                }
                if (tau == 0) {
#pragma unroll
                    for (int j = 0; j < 4; ++j) if (coq + 4 * j == ci) kv[j] += dsk[16 * g + ci];
                }
            }
            const int at = tau < 0 ? -tau : tau;
#pragma unroll
            for (int j = 0; j < 4; ++j) {
                const bf16_t hv = (bf16_t)f2bf(kv[j]); const int co = coq + 4 * j;
                for (int q = 0; q < 32 - at; ++q) { const int ii = tau >= 0 ? q + tau : q, ip = tau >= 0 ? q : q + at; BtY[(size_t)(g * 512 + ii * 16 + co) * AYP + ip * 16 + ci] = hv; }
            }
        }
        const pg8::Gemm g = mk_gemm(XB, Win, T, INW, D); pg8::StaticOrder S; S.init(T, INW, G, bid);
        pg8::EpiZ E{Qp, Kp, Vtp, AY, Gt, ss1, P.in[7]};
        pg8::gemm_phase<pg8::EpiZ, pg8::StaticOrder, true, true>(lds, g, S, E);
    }
    SEAM(3);
    if (IN_PH(4)) for (int rep = 0; rep < REPS(4); ++rep) {
        { const pg8::Gemm g{AY, BtX, T, 256, 512, AYP, 512, 4, (size_t)256 * 512 * 2}; pg8::StaticOrder S; S.init(T, 256, G, bid);
          pg8::EpiX E{Xs};
          pg8::gemm_phase<pg8::EpiX, pg8::StaticOrder, true, true>(lds, g, S, E); }
        __syncthreads();
        constexpr int AT_K = 6400, AT_V = AT_K + 32768;
        LAS float* lut = (LAS float*)lds;
        for (int i = tid; i < 12 * 132; i += NTHREADS) lut[i] = lutg[i];
        const int fr = lane & 15, fq = lane >> 4;
        constexpr int NU = NB * NH * 64;
        u32x4 kreg[4], vreg[4]; bf16x8 qreg[2];
#define AT_DECODE(bu_) const int bh = (bu_) >> 6, blk = (bu_) & 63, b = bh / NH, h = bh - b * NH, g = h >> 2, sh = 2 * g, lm = 13 - sh; \
        const int tq0 = blk * 128, r = tq0 >> lm, mb = tq0 & ((1 << lm) - 1), rbase = r << lm; \
        const bf16_t* Qb = Qp + (size_t)bh * L * 64; const bf16_t* Kb = Kp + (size_t)bh * L * 64; const bf16_t* Vb = Vtp + (size_t)bh * 64 * L;
#define AT_ISSUE(bu_) do { AT_DECODE(bu_) (void)b; (void)g; (void)sh; \
            _Pragma("unroll") for (int j = 0; j < 4; ++j) { const int c = tid + 512 * j, key = c >> 3, part = c & 7; \
                kreg[j] = (mb > 0 || key >= 128) ? *(const u32x4*)(Kb + (size_t)(rbase + mb - 128 + key) * 64 + part * 8) : (u32x4){0u, 0u, 0u, 0u}; } \
            _Pragma("unroll") for (int j = 0; j < 4; ++j) { const int c = tid + 512 * j, d = c >> 5, part = c & 31; \
                vreg[j] = (mb > 0 || part >= 16) ? *(const u32x4*)(Vb + (size_t)d * L + rbase + mb - 128 + part * 8) : (u32x4){0u, 0u, 0u, 0u}; } \
            _Pragma("unroll") for (int ks = 0; ks < 2; ++ks) qreg[ks] = *(const bf16x8*)(Qb + (size_t)(tq0 + 16 * wave + fr) * 64 + 32 * ks + 8 * fq); } while (0)
        int bu = bid;
        if (bu < NU) AT_ISSUE(bu);
        while (bu < NU) {
#pragma unroll
            for (int j = 0; j < 4; ++j) { const int c = tid + 512 * j, key = c >> 3, part = c & 7; *(LAS u32x4*)(lds + AT_K + key * 128 + ((part ^ (key & 7)) << 4)) = kreg[j]; }
#pragma unroll
            for (int j = 0; j < 4; ++j) { const int c = tid + 512 * j, d = c >> 5, part = c & 31; *(LAS u32x4*)(lds + AT_V + d * 512 + ((part ^ (d & 15)) << 4)) = vreg[j]; }
            const bf16x8 qf0 = qreg[0], qf1 = qreg[1];
            __syncthreads();
            const int nbu = bu + G;
            if (nbu < NU) AT_ISSUE(nbu);
            {
                AT_DECODE(bu) (void)Qb; (void)Kb; (void)Vb; (void)rbase;
                const int m0 = mb + 16 * wave;
                const LAS float* luth = lut + h * 132;
                float s[9][4];
#pragma unroll
                for (int kt = 1; kt <= 9; ++kt) {
                    const int kb = m0 - 144 + 16 * kt, krel = 16 * wave - 16 + 16 * kt;
                    if (kb >= 0) {
                        const int row = krel + fr;
                        const bf16x8 k0 = *(const LAS bf16x8*)(lds + AT_K + row * 128 + ((fq ^ (row & 7)) << 4));
                        const bf16x8 k1 = *(const LAS bf16x8*)(lds + AT_K + row * 128 + (((fq + 4) ^ (row & 7)) << 4));
                        f32x4 a = (f32x4){0.f, 0.f, 0.f, 0.f};
                        a = __builtin_amdgcn_mfma_f32_16x16x32_bf16(k0, qf0, a, 0, 0, 0);
                        a = __builtin_amdgcn_mfma_f32_16x16x32_bf16(k1, qf1, a, 0, 0, 0);
#pragma unroll
                        for (int i = 0; i < 4; ++i) { const int st = (m0 + fr) - (kb + 4 * fq + i); const bool ok = (st >= 0) && (st <= 128);
                            const int sc = st < 0 ? 0 : (st > 128 ? 128 : st); s[kt - 1][i] = ok ? a[i] + luth[sc] : -1e30f; }
                    } else {
#pragma unroll
                        for (int i = 0; i < 4; ++i) s[kt - 1][i] = -1e30f;
                    }
                }
                float mx = -1e30f;
#pragma unroll
                for (int kt = 0; kt < 9; ++kt)
#pragma unroll
                    for (int i = 0; i < 4; ++i) mx = fmaxf(mx, s[kt][i]);
                mx = fmaxf(mx, __shfl_xor(mx, 16)); mx = fmaxf(mx, __shfl_xor(mx, 32));
                float lsum = 0.f;
#pragma unroll
                for (int kt = 0; kt < 9; ++kt)
#pragma unroll
                    for (int i = 0; i < 4; ++i) { s[kt][i] = __expf(s[kt][i] - mx); lsum += s[kt][i]; }
                lsum += __shfl_xor(lsum, 16); lsum += __shfl_xor(lsum, 32);
                f32x4 oacc[4];
#pragma unroll
                for (int dt = 0; dt < 4; ++dt) oacc[dt] = (f32x4){0.f, 0.f, 0.f, 0.f};
#pragma unroll
                for (int kp = 0; kp < 5; ++kp) {
                    const int kb0 = m0 - 144 + 32 * kp, kb1 = kb0 + 16, krel0 = 16 * wave - 16 + 32 * kp;
                    u32x4 pw;
                    if (kp == 0) { pw.x = 0u; pw.y = 0u; } else { pw.x = pg8::cvt_pk_bf16(s[2 * kp - 1][0], s[2 * kp - 1][1]); pw.y = pg8::cvt_pk_bf16(s[2 * kp - 1][2], s[2 * kp - 1][3]); }
                    pw.z = pg8::cvt_pk_bf16(s[2 * kp][0], s[2 * kp][1]); pw.w = pg8::cvt_pk_bf16(s[2 * kp][2], s[2 * kp][3]);
                    const bf16x8 pf = __builtin_bit_cast(bf16x8, pw);
                    if (kb1 >= 0) {
                        const int u0 = (krel0 >> 2) + fq;
#pragma unroll
                        for (int dt = 0; dt < 4; ++dt) {
                            const int row = 16 * dt + fr;
                            u32x2 lo2 = (u32x2){0u, 0u};
                            if (kp > 0 && kb0 >= 0) lo2 = *(const LAS u32x2*)(lds + AT_V + row * 512 + (((u0 >> 1) ^ (row & 15)) << 4) + ((u0 & 1) << 3));
                            const u32x2 hi2 = *(const LAS u32x2*)(lds + AT_V + row * 512 + ((((u0 + 4) >> 1) ^ (row & 15)) << 4) + ((u0 & 1) << 3));
                            const u32x4 vw = (u32x4){lo2.x, lo2.y, hi2.x, hi2.y};
                            oacc[dt] = __builtin_amdgcn_mfma_f32_16x16x32_bf16(__builtin_bit_cast(bf16x8, vw), pf, oacc[dt], 0, 0, 0);
                        }
                    }
                }
                const float inv = 1.0f / lsum;
                const int tok = b * L + ((m0 + fr) << sh) + r;
                bf16_t* op = Og + ((size_t)g * T + tok) * 256 + (h & 3) * 64 + 4 * fq;
#pragma unroll
                for (int dt = 0; dt < 4; ++dt) { u32x2 w; w.x = pg8::cvt_pk_bf16(oacc[dt][0] * inv, oacc[dt][1] * inv); w.y = pg8::cvt_pk_bf16(oacc[dt][2] * inv, oacc[dt][3] * inv); *(u32x2*)(op + 16 * dt) = w; }
                if (fq == 0) LSE[((size_t)g * T + tok) * 4 + (h & 3)] = mx + __logf(lsum);
            }
            __syncthreads();
            bu = nbu;
        }
#undef AT_DECODE
#undef AT_ISSUE
        __syncthreads();
    }
    SEAM(4);
    if (IN_PH(5)) for (int rep = 0; rep < REPS(5); ++rep) {
        for (int item = bid; item < 128; item += G) {
            LAS float* ex = (LAS float*)lds;
            const int b = item >> 5, g = item & 31, gn = g * 64 + lane;
            const float a32r = apow[(size_t)gn * 66 + 64], a32i = apow[(size_t)gn * 66 + 65];
            const size_t R0 = (size_t)(g * 1024 + b * 256 + 32 * wave);
            f32x2 xv[32];
#pragma unroll
            for (int k = 0; k < 32; ++k) xv[k] = *(const f32x2*)(Xs + (R0 + k) * 128 + 2 * lane);
            float sre = 0.f, sim = 0.f;
#pragma unroll
            for (int k = 0; k < 32; ++k) { const float nr = a32r * sre - a32i * sim + xv[k][0], ni = a32r * sim + a32i * sre + xv[k][1]; sre = nr; sim = ni; }
            __syncthreads();
            ex[(wave * 64 + lane) * 2] = sre; ex[(wave * 64 + lane) * 2 + 1] = sim;
            float pr = a32r, pi = a32i;
#pragma unroll
            for (int q = 0; q < 5; ++q) { const float nr = pr * pr - pi * pi, ni = 2.f * pr * pi; pr = nr; pi = ni; }
            __syncthreads();
            sre = 0.f; sim = 0.f;
            for (int v = 0; v < wave; ++v) { const float er = ex[(v * 64 + lane) * 2], ei = ex[(v * 64 + lane) * 2 + 1]; const float nr = pr * sre - pi * sim + er, ni = pr * sim + pi * sre + ei; sre = nr; sim = ni; }
#pragma unroll
            for (int k = 0; k < 32; ++k) {
                *(unsigned*)(AY + (R0 + k) * AYP + 512 + 2 * lane) = pg8::cvt_pk_bf16(sre, sim);
                const float nr = a32r * sre - a32i * sim + xv[k][0], ni = a32r * sim + a32i * sre + xv[k][1]; sre = nr; sim = ni;
            }
        }
        for (int it = gw; it < T / 2; it += NGW) {
            const int tok = it * 2 + (lane >> 5), ch = lane & 31, j = ch >> 3;
            const float l0 = LSE[((size_t)0 * T + tok) * 4 + j], l1 = LSE[((size_t)1 * T + tok) * 4 + j], l2 = LSE[((size_t)2 * T + tok) * 4 + j];
            const float mx = fmaxf(l0, fmaxf(l1, l2)); const float e0 = __expf(l0 - mx), e1 = __expf(l1 - mx), e2 = __expf(l2 - mx); const float inv = 1.0f / (e0 + e1 + e2);
            f32x4 a0, a1, b0, b1, c0, c1;
            pg8::unpack8(*(const u32x4*)(Og + ((size_t)0 * T + tok) * 256 + 8 * ch), a0, a1);
            pg8::unpack8(*(const u32x4*)(Og + ((size_t)1 * T + tok) * 256 + 8 * ch), b0, b1);
            pg8::unpack8(*(const u32x4*)(Og + ((size_t)2 * T + tok) * 256 + 8 * ch), c0, c1);
            const float w0 = e0 * inv, w1 = e1 * inv, w2 = e2 * inv;
            *(u32x4*)(Oc + (size_t)tok * 256 + 8 * ch) = pg8::pack8(a0 * w0 + b0 * w1 + c0 * w2, a1 * w0 + b1 * w1 + c1 * w2);
        }
        __syncthreads();
    }
    SEAM(5);
    if (IN_PH(6)) for (int rep = 0; rep < REPS(6); ++rep) {
        { const pg8::Gemm g{AY, BtY, T, 512, AYP, AYP, AYP, 4, (size_t)512 * AYP * 2}; pg8::StaticOrder S; S.init(T, 512, G, bid);
          pg8::EpiY E{Yg};
          pg8::gemm_phase<pg8::EpiY, pg8::StaticOrder, true, true>(lds, g, S, E); }
        { const pg8::Gemm g = mk_gemm(Oc, Wa, T, D, 256); pg8::StaticOrder S; S.init(T, D, G, bid);
          pg8::EpiGateMul E{M1, Gt};
          pg8::gemm_phase<pg8::EpiGateMul, pg8::StaticOrder, true, true>(lds, g, S, E); }
    }
    SEAM(6);
    if (IN_PH(7)) for (int rep = 0; rep < REPS(7); ++rep) {
        const pg8::Gemm g = mk_gemm(Yg, Wglu, T, D, 512); pg8::StaticOrder S; S.init(T, D, G, bid);
        pg8::EpiGlu E{Ys};
        pg8::gemm_phase<pg8::EpiGlu, pg8::StaticOrder, true, true>(lds, g, S, E);
    }
    SEAM(7);
    if (IN_PH(8)) for (int rep = 0; rep < REPS(8); ++rep) {
        const pg8::Gemm g = mk_gemm(Ys, Wsb, T, D, 512); pg8::StaticOrder S; S.init(T, D, G, bid);
        pg8::EpiMerge E{MG, M1, Gt + 1024};
        pg8::gemm_phase<pg8::EpiMerge, pg8::StaticOrder, true, true>(lds, g, S, E);
    }
    SEAM(8);
    if (IN_PH(9)) for (int rep = 0; rep < REPS(9); ++rep) {
        const pg8::Gemm g = mk_gemm(MG, Wout, T, D, D); pg8::StaticOrder S; S.init(T, D, G, bid);
        pg8::EpiResid E{out, rep ? dumF : out, rep ? dumB : XB, rep ? ssd : ss2, 1.0f};
        pg8::gemm_phase<pg8::EpiResid, pg8::StaticOrder, true, true>(lds, g, S, E);
    }
    SEAM(9);
    if (IN_PH(10)) for (int rep = 0; rep < REPS(10); ++rep) {
        const pg8::Gemm g = mk_gemm(XB, Wgu2, T, 2 * FF, D); pg8::StaticOrder S; S.init(T, 2 * FF, G, bid);
        pg8::EpiSwiglu E{A1, FF, ss2};
        pg8::gemm_phase<pg8::EpiSwiglu, pg8::StaticOrder, true, true>(lds, g, S, E);
    }
    SEAM(10);
    if (IN_PH(11)) for (int rep = 0; rep < REPS(11); ++rep) {
        const pg8::Gemm g = mk_gemm(A1, Wd2, T, D, FF); pg8::StaticOrder S; S.init(T, D, G, bid);
        pg8::EpiResid E{out, rep ? dumF : out, nullptr, rep ? ssd : ss3, 0.5f};
        pg8::gemm_phase<pg8::EpiResid, pg8::StaticOrder, true, true>(lds, g, S, E);
    }
    SEAM(11);
    if (IN_PH(12)) for (int rep = 0; rep < REPS(12); ++rep) {
        const float* gf = P.in[25];
        for (int r = gw; r < T; r += NGW) {
            const float rinv = 1.0f / sqrtf(ss3[r] * (1.0f / D) + EPS);
            f32x4* xr = (f32x4*)(out + (size_t)r * D) + lane; f32x4* xw = (f32x4*)((rep ? dumF : out) + (size_t)r * D) + lane;
#pragma unroll
            for (int j = 0; j < 4; ++j) { const f32x4 gg = ((const f32x4*)gf)[lane + 64 * j]; xw[64 * j] = xr[64 * j] * rinv * gg; }
        }
    }
#undef IN_PH
#undef SEAM
}

extern "C" void kernel_launch(void* const* d_in, const int* in_sizes, int n_in, void* d_out, int out_size, void* d_ws, size_t ws_size, hipStream_t stream) {
    static int grid = 0;
    if (grid == 0) {
        if (n_in != 26 || ws_size < WS_END) { fprintf(stderr, "kernel_launch: expected 26 inputs and >= %zu bytes of workspace; got %d, %zu\n", (size_t)WS_END, n_in, ws_size); grid = -1; return; }
        int dev = 0, cus = 0, per_cu = 0;
        (void)hipGetDevice(&dev); (void)hipDeviceGetAttribute(&cus, hipDeviceAttributeMultiprocessorCount, dev);
        if (hipFuncSetAttribute((const void*)fwd_kernel, hipFuncAttributeMaxDynamicSharedMemorySize, LDS_BYTES) != hipSuccess) { fprintf(stderr, "kernel_launch: hipFuncSetAttribute failed\n"); grid = -1; return; }
        (void)hipOccupancyMaxActiveBlocksPerMultiprocessor(&per_cu, (const void*)fwd_kernel, NTHREADS, LDS_BYTES);
        if (per_cu < 1) { fprintf(stderr, "kernel_launch: occupancy query says %d blocks per CU\n", per_cu); per_cu = 1; }
        (void)hipGetLastError();
        grid = cus;
        fprintf(stderr, "kernel_launch: grid %d (CUs %d, occupancy %d per CU)\n", grid, cus, per_cu);
    }
    if (grid < 0) return;
    Params p{};
    for (int i = 0; i < 26; ++i) p.in[i] = (const float*)d_in[i];
    p.out = (float*)d_out; p.ws = (unsigned char*)d_ws;
    for (int g = 0; g < 3; ++g) { const int dil = g == 0 ? 1 : (g == 1 ? 4 : 16);
        for (int s = 0; s <= 128; ++s) { const int dist = s * dil; int bkt;
            if (dist < 16) bkt = dist; else { const float dd = (float)dist; int large = 16 + (int)(logf(dd / 16.0f) / (float)log(128.0) * 16.0f); if (large > 31) large = 31; bkt = large; }
            p.bk[g][s] = (unsigned char)bkt; } }
#if ONE_LAUNCH
    if (hipMemsetAsync((char*)d_ws + WS_BAR, 0, BAR_ZERO_BYTES, stream) != hipSuccess) { fprintf(stderr, "kernel_launch: memset failed\n"); return; }
    p.ph_lo = 0; p.ph_hi = N_PHASES;
    void* args[] = {&p};
    hipError_t e = hipLaunchCooperativeKernel((const void*)fwd_kernel, dim3(grid), dim3(NTHREADS), args, LDS_BYTES, stream);
    if (e != hipSuccess) fprintf(stderr, "cooperative launch failed: %s (grid %d)\n", hipGetErrorString(e), grid);
#else
    for (int ph = 0; ph < N_PHASES; ++ph) { p.ph_lo = ph; p.ph_hi = ph + 1; hipLaunchKernelGGL(fwd_kernel, dim3(grid), dim3(NTHREADS), LDS_BYTES, stream, p); }
#endif
}
```

```cpp
#include <hip/hip_runtime.h>
#include <hip/hip_cooperative_groups.h>
#include <cstdio>
#include <cstdint>
#include <cmath>
namespace cg = cooperative_groups;
#ifndef ONE_LAUNCH
#define ONE_LAUNCH 1
#endif
namespace pg8 {
#define PG8_LAS __attribute__((address_space(3)))
typedef unsigned short bf16_t;
typedef short bf16x8 __attribute__((ext_vector_type(8)));
typedef float f32x4 __attribute__((ext_vector_type(4)));
typedef unsigned u32x4 __attribute__((ext_vector_type(4)));
constexpr int BM = 256, BK = 64, HALF = 128, HTB = HALF * BK * 2  , STAGE_BYTES = 8 * HTB, NXCD = 8, WGM = 8;

__host__ __device__ __forceinline__ int lds_byte(int r, int c) { const int st = (r >> 4) * 2 + (c >> 5), rr = r & 15, cc = c & 31, ob = rr * 64 + cc * 2; return st * 1024 + (ob ^ (((ob >> 9) & 1) << 5)); }
__host__ __device__ __forceinline__ void stage_rc(int b, int& R, int& C) { const int st = b / 1024, sb = b % 1024, swz = sb ^ (((sb >> 9) & 1) << 5); R = (st >> 1) * 16 + swz / 64; C = (st & 1) * 32 + (swz % 64) / 2; }
__host__ __device__ __forceinline__ int perm32(int rho) { const int n = rho >> 4, i = rho & 15; return 8 * (i >> 2) + 4 * n + (i & 3); }

struct Unit { int pm, pn; };
struct Gemm { const bf16_t* A; const bf16_t* Bt; int M, N, K, lda, ldb, mtpg; size_t bgs; };

struct StaticOrder {
    int nM, nN, nwg, G, c;
    __host__ __device__ void init(int M, int N, int G_, int c_) { nM = M / BM; nN = N / BM; nwg = nM * nN; G = G_; c = c_; }
    __host__ __device__ bool next(int i, Unit& u) const {
        const long L = (long)i * G + c; if (L >= nwg) return false;
        int wgid = (int)L; { const int q = nwg / NXCD, r = nwg % NXCD, xcd = wgid % NXCD, off = wgid / NXCD; wgid = (xcd < r ? xcd * (q + 1) : r * (q + 1) + (xcd - r) * q) + off; }
        const int nig = WGM * nN, gid = wgid / nig, fm = gid * WGM, gsz = (nM - fm) < WGM ? (nM - fm) : WGM;
        u.pm = fm + ((wgid % nig) % gsz); u.pn = (wgid % nig) / gsz; return true;
    }
    __device__ __forceinline__ void a_ready(const Unit&) const {}
    __device__ __forceinline__ void done(const Unit&) const {}
};


constexpr float RMS_EPS = 1e-6f;
constexpr int TOK = 32768, DM = 1024, SEQL = 8192;
typedef float f32x2_t __attribute__((ext_vector_type(2))); typedef __bf16 bf16x2_t __attribute__((ext_vector_type(2)));
__device__ __forceinline__ unsigned cvt_pk_bf16(float lo, float hi) { const f32x2_t v = {lo, hi}; const bf16x2_t b = __builtin_convertvector(v, bf16x2_t); return __builtin_bit_cast(unsigned, b); }
__device__ __forceinline__ u32x4 pack8(const f32x4& a, const f32x4& b) { u32x4 w; w.x = cvt_pk_bf16(a[0], a[1]); w.y = cvt_pk_bf16(a[2], a[3]); w.z = cvt_pk_bf16(b[0], b[1]); w.w = cvt_pk_bf16(b[2], b[3]); return w; }
__device__ __forceinline__ float bf_lo(unsigned w) { return __uint_as_float(w << 16); }
__device__ __forceinline__ float bf_hi(unsigned w) { return __uint_as_float(w & 0xffff0000u); }
__device__ __forceinline__ void unpack8(const u32x4& w, f32x4& a, f32x4& b) { a = (f32x4){bf_lo(w.x), bf_hi(w.x), bf_lo(w.y), bf_hi(w.y)}; b = (f32x4){bf_lo(w.z), bf_hi(w.z), bf_lo(w.w), bf_hi(w.w)}; }
__device__ __forceinline__ float sigm(float x) { return __builtin_amdgcn_rcpf(1.f + __expf(-x)); }
__device__ __forceinline__ f32x4 sigm4(const f32x4& x) { return (f32x4){sigm(x[0]), sigm(x[1]), sigm(x[2]), sigm(x[3])}; }
__device__ __forceinline__ float row_rs(const float* ss, int row) { return ss ? __builtin_amdgcn_rsqf(ss[row] * (1.0f / 1024.0f) + RMS_EPS) : 1.0f; }

struct EpiSwiglu {
    static constexpr bool PERM = true, AFTER_DRAIN = false;
    bf16_t* O; int ldo; const float* ss;
    __device__ __forceinline__ void operator()(const f32x4 (&acc)[2][2][4][2], const Unit& u, int wr, int wc, int fr, int fq) const {
        const int col0 = u.pn * 128 + wc * 32 + 8 * fq;
#pragma unroll
        for (int ai = 0; ai < 2; ++ai)
#pragma unroll
            for (int m = 0; m < 4; ++m) {
                const int row = u.pm * BM + ai * HALF + wr * 64 + m * 16 + fr; const float rs = row_rs(ss, row);
                f32x4 o[2];
#pragma unroll
                for (int n = 0; n < 2; ++n) { const f32x4 g = acc[ai][0][m][n] * rs, up = acc[ai][1][m][n] * rs; o[n] = g * sigm4(g) * up; }
                *(u32x4*)(O + (size_t)row * ldo + col0) = pack8(o[0], o[1]);
            }
    }
};
struct EpiResid {
    static constexpr bool PERM = true, AFTER_DRAIN = false;
    const float* base; float* out; bf16_t* xb; float* ss; float alpha;
    __device__ __forceinline__ void operator()(const f32x4 (&acc)[2][2][4][2], const Unit& u, int wr, int wc, int fr, int fq) const {
        const int col0 = u.pn * BM + wc * 32 + 8 * fq;
#pragma unroll
        for (int ai = 0; ai < 2; ++ai)
#pragma unroll
            for (int m = 0; m < 4; ++m) {
                const int row = u.pm * BM + ai * HALF + wr * 64 + m * 16 + fr; float sq = 0.f;
#pragma unroll
                for (int bj = 0; bj < 2; ++bj) {
                    const size_t off = (size_t)row * DM + col0 + bj * HALF;
                    const f32x4 b0 = *(const f32x4*)(base + off), b1 = *(const f32x4*)(base + off + 4);
                    const f32x4 x0 = b0 + acc[ai][bj][m][0] * alpha, x1 = b1 + acc[ai][bj][m][1] * alpha;
                    *(f32x4*)(out + off) = x0; *(f32x4*)(out + off + 4) = x1;
                    if (xb) *(u32x4*)(xb + off) = pack8(x0, x1);
                    sq += (x0[0] * x0[0] + x0[1] * x0[1]) + (x0[2] * x0[2] + x0[3] * x0[3]) + (x1[0] * x1[0] + x1[1] * x1[1]) + (x1[2] * x1[2] + x1[3] * x1[3]);
                }
                if (ss) { sq += __shfl_xor(sq, 16); sq += __shfl_xor(sq, 32); if (fq == 0) unsafeAtomicAdd(ss + row, sq); }
                asm volatile("" ::: "memory");
            }
    }
};
struct EpiZ {
    static constexpr bool PERM = true, AFTER_DRAIN = false;
    bf16_t *QKV, *U, *G; const float* ss; const float* gbias;
    __device__ __forceinline__ void operator()(const f32x4 (&acc)[2][2][4][2], const Unit& u, int wr, int wc, int fr, int fq) const {
        const int pn = u.pn;
        const float qs = pn < 3 ? 0.125f : 1.0f;
#pragma unroll
        for (int ai = 0; ai < 2; ++ai)
#pragma unroll
            for (int m = 0; m < 4; ++m) {
                const int row = u.pm * BM + ai * HALF + wr * 64 + m * 16 + fr; const float rs = row_rs(ss, row);
                const int b = row >> 13, tt = row & (SEQL - 1);
#pragma unroll
                for (int bj = 0; bj < 2; ++bj) {
                    f32x4 z0 = acc[ai][bj][m][0] * rs, z1 = acc[ai][bj][m][1] * rs;
                    const int ct = bj * HALF + wc * 32 + 8 * fq;
                    if (pn < 9) {
                        *(u32x4*)(QKV + (size_t)row * 2304 + pn * BM + ct) = pack8(z0 * qs, z1 * qs);
                    } else if (pn < 11) {
                        const int cu = (pn - 9) * BM + ct, gg = cu >> 4;
                        *(u32x4*)(U + ((size_t)(gg * 1024 + b * 256 + (tt >> 5)) * 640 + (tt & 31) * 16 + (cu & 15))) = pack8(z0, z1);
                    } else {
                        const int cg_ = (pn - 11) * BM + ct;
                        const f32x4 g0 = *(const f32x4*)(gbias + cg_), g1 = *(const f32x4*)(gbias + cg_ + 4);
                        z0 = sigm4(z0 + g0); z1 = sigm4(z1 + g1);
                        *(u32x4*)(G + (size_t)row * 2048 + cg_) = pack8(z0, z1);
                    }
                }
            }
    }
};
struct EpiGateMul {
    static constexpr bool PERM = true, AFTER_DRAIN = false;
    bf16_t* O; const bf16_t* Gt;
    __device__ __forceinline__ void operator()(const f32x4 (&acc)[2][2][4][2], const Unit& u, int wr, int wc, int fr, int fq) const {
        const int col0 = u.pn * BM + wc * 32 + 8 * fq;
#pragma unroll
        for (int ai = 0; ai < 2; ++ai)
#pragma unroll
            for (int m = 0; m < 4; ++m) {
                const int row = u.pm * BM + ai * HALF + wr * 64 + m * 16 + fr;
#pragma unroll
                for (int bj = 0; bj < 2; ++bj) {
                    const int c = col0 + bj * HALF; f32x4 g0, g1; unpack8(*(const u32x4*)(Gt + (size_t)row * 2048 + c), g0, g1);
                    *(u32x4*)(O + (size_t)row * DM + c) = pack8(acc[ai][bj][m][0] * g0, acc[ai][bj][m][1] * g1);
                }
                asm volatile("" ::: "memory");
            }
    }
};
struct EpiGlu {
    static constexpr bool PERM = true, AFTER_DRAIN = false;
    bf16_t* O;
    __device__ __forceinline__ void operator()(const f32x4 (&acc)[2][2][4][2], const Unit& u, int wr, int wc, int fr, int fq) const {
        const int col0 = u.pn * 128 + wc * 32 + 8 * fq;
#pragma unroll
        for (int ai = 0; ai < 2; ++ai)
#pragma unroll
            for (int m = 0; m < 4; ++m) {
                const int row = u.pm * BM + ai * HALF + wr * 64 + m * 16 + fr;
                *(u32x4*)(O + (size_t)row * 512 + col0) = pack8(acc[ai][0][m][0] * sigm4(acc[ai][1][m][0]), acc[ai][0][m][1] * sigm4(acc[ai][1][m][1]));
            }
    }
};
struct EpiMerge {
    static constexpr bool PERM = true, AFTER_DRAIN = false;
    bf16_t* O; const bf16_t* M1; const bf16_t* Gt;
    __device__ __forceinline__ void operator()(const f32x4 (&acc)[2][2][4][2], const Unit& u, int wr, int wc, int fr, int fq) const {
        const int col0 = u.pn * BM + wc * 32 + 8 * fq;
#pragma unroll
        for (int ai = 0; ai < 2; ++ai)
#pragma unroll
            for (int m = 0; m < 4; ++m) {
                const int row = u.pm * BM + ai * HALF + wr * 64 + m * 16 + fr;
#pragma unroll
                for (int bj = 0; bj < 2; ++bj) {
                    const int c = col0 + bj * HALF; f32x4 g0, g1, a0, a1;
                    unpack8(*(const u32x4*)(Gt + (size_t)row * 2048 + c), g0, g1); unpack8(*(const u32x4*)(M1 + (size_t)row * DM + c), a0, a1);
                    *(u32x4*)(O + (size_t)row * DM + c) = pack8(a0 + acc[ai][bj][m][0] * g0, a1 + acc[ai][bj][m][1] * g1);
                }
                asm volatile("" ::: "memory");
            }
    }
};


struct EpiX {
    static constexpr bool PERM = true, AFTER_DRAIN = false;
    float* X;
    __device__ __forceinline__ void operator()(const f32x4 (&acc)[2][2][4][2], const Unit& u, int wr, int wc, int fr, int fq) const {
        const int col0 = wc * 32 + 8 * fq;
#pragma unroll
        for (int ai = 0; ai < 2; ++ai)
#pragma unroll
            for (int m = 0; m < 4; ++m) {
                const int row = u.pm * BM + ai * HALF + wr * 64 + m * 16 + fr;
                *(f32x4*)(X + (size_t)row * 128 + col0) = acc[ai][0][m][0]; *(f32x4*)(X + (size_t)row * 128 + col0 + 4) = acc[ai][0][m][1];
            }
    }
};
__device__ __forceinline__ float gelu_tanh_(float x) {
    const float u = 0.7978845608028654f * (x + 0.044715f * x * x * x);
    const float e = __expf(2.f * u);
    return 0.5f * x * (2.f - 2.f * __builtin_amdgcn_rcpf(e + 1.f));
}
__device__ __forceinline__ f32x4 gelu4(const f32x4& x) { return (f32x4){gelu_tanh_(x[0]), gelu_tanh_(x[1]), gelu_tanh_(x[2]), gelu_tanh_(x[3])}; }
struct EpiY {
    static constexpr bool PERM = true, AFTER_DRAIN = false;
    bf16_t* Y;
    __device__ __forceinline__ void operator()(const f32x4 (&acc)[2][2][4][2], const Unit& u, int wr, int wc, int fr, int fq) const {
#pragma unroll
        for (int ai = 0; ai < 2; ++ai)
#pragma unroll
            for (int m = 0; m < 4; ++m) {
                const int R = u.pm * BM + ai * HALF + wr * 64 + m * 16 + fr, gg = R >> 10, b = (R >> 8) & 3, k = R & 255;
#pragma unroll
                for (int bj = 0; bj < 2; ++bj) {
                    const int c = u.pn * BM + bj * HALF + wc * 32 + 8 * fq, i = c >> 4;
                    *(u32x4*)(Y + (size_t)(b * SEQL + 32 * k + i) * 512 + 16 * gg + (c & 15)) = pack8(gelu4(acc[ai][bj][m][0]), gelu4(acc[ai][bj][m][1]));
                }
            }
    }
};
template <class Epi, class Sched, bool ALIGN_EPI = false, bool SP2 = false>
__device__ __forceinline__ void gemm_phase(PG8_LAS unsigned char* lds, const Gemm g, const Sched& S, const Epi& E) {
    int tid_ = threadIdx.x; asm volatile("" : "+v"(tid_) :: "memory");
    const int tid = tid_, wid = __builtin_amdgcn_readfirstlane(tid >> 6), lane = tid & 63, wr = wid >> 2, wc = wid & 3, fr = lane & 15, fq = lane >> 4;
    const int K = g.K, nt = K / BK;
    unsigned voffA[2], voffB[2];
#pragma unroll
    for (int i = 0; i < 2; ++i) { int R, C; stage_rc(tid * 16 + i * 8192, R, C); const int Rb = Epi::PERM ? ((R & ~31) + perm32(R & 31)) : R;
        voffA[i] = (unsigned)(R * g.lda + C) * 2u; voffB[i] = (unsigned)(Rb * g.ldb + C) * 2u; }
    const size_t kstep = (size_t)(BK * 2);
    const size_t hstepA = (size_t)HALF * g.lda * 2, hstepB = (size_t)HALF * g.ldb * 2;
    const size_t tstepA = 2 * hstepA, tstepB = 2 * hstepB;
    const unsigned ldsw = (unsigned)wid * 1024u;
    const int aoff = lds_byte(wr * 64 + fr, fq * 8), boff = lds_byte(wc * 32 + fr, fq * 8);
#define PG8_SA(b, h) (((b) * 2 + (h)) * HTB)
#define PG8_SB(b, h) ((4 + (b) * 2 + (h)) * HTB)
#define PG8_STAGE(bufoff, gbase, voff) do { _Pragma("unroll") for (int _i = 0; _i < 2; ++_i) \
        __builtin_amdgcn_global_load_lds((const unsigned*)((const char*)(gbase) + (voff)[_i]), (PG8_LAS unsigned*)(lds + (bufoff) + ldsw + _i * 8192), 16, 0, 0); } while (0)
#define PG8_LDA(dst, b, h) do { _Pragma("unroll") for (int m = 0; m < 4; ++m) _Pragma("unroll") for (int k = 0; k < 2; ++k) dst[m][k] = *(const PG8_LAS bf16x8*)(lds + PG8_SA(b, h) + aoff + m * 2048 + k * 1024); } while (0)
#define PG8_LDB(dst, b, h) do { _Pragma("unroll") for (int n = 0; n < 2; ++n) _Pragma("unroll") for (int k = 0; k < 2; ++k) dst[n][k] = *(const PG8_LAS bf16x8*)(lds + PG8_SB(b, h) + boff + n * 2048 + k * 1024); } while (0)
#define PG8_MMA(ai, bj, At, Bt) do { __builtin_amdgcn_s_setprio(1); _Pragma("unroll") for (int m = 0; m < 4; ++m) _Pragma("unroll") for (int n = 0; n < 2; ++n) _Pragma("unroll") for (int k = 0; k < 2; ++k) \
        acc[ai][bj][m][n] = __builtin_amdgcn_mfma_f32_16x16x32_bf16(Bt[n][k], At[m][k], acc[ai][bj][m][n], 0, 0, 0); __builtin_amdgcn_s_setprio(0); } while (0)
#define PG8_WAIT_V(n) asm volatile("s_waitcnt vmcnt(" #n ")" ::: "memory")
#define PG8_WAIT_L(n) asm volatile("s_waitcnt lgkmcnt(" #n ")" ::: "memory")
#define PG8_BAR __builtin_amdgcn_s_barrier()
#define PG8_SCHED __builtin_amdgcn_sched_barrier(0)
    Unit cur, nxt; int ui = 0;
    if (!S.next(0, cur)) return;
    f32x4 acc[2][2][4][2];
#pragma unroll
    for (int a = 0; a < 2; ++a)
#pragma unroll
        for (int b = 0; b < 2; ++b)
#pragma unroll
            for (int m = 0; m < 4; ++m)
#pragma unroll
                for (int n = 0; n < 2; ++n) acc[a][b][m][n] = (f32x4){0.f, 0.f, 0.f, 0.f};
    bf16x8 At[4][2], B0[2][2], B1[2][2];
    const char* cA = (const char*)g.A + (size_t)cur.pm * tstepA; const char* cB = (const char*)g.Bt + (size_t)cur.pn * tstepB + (size_t)(cur.pm / g.mtpg) * g.bgs;
    S.a_ready(cur);
    if constexpr (SP2) {
        PG8_STAGE(PG8_SB(0, 0), cB, voffB); PG8_STAGE(PG8_SB(0, 1), cB + hstepB, voffB); PG8_STAGE(PG8_SA(0, 0), cA, voffA); PG8_STAGE(PG8_SA(0, 1), cA + hstepA, voffA);
        if (wr == 1) PG8_BAR;
        PG8_WAIT_V(2); PG8_BAR;
        PG8_STAGE(PG8_SB(1, 0), cB + kstep, voffB); PG8_STAGE(PG8_SA(1, 0), cA + kstep, voffA); PG8_STAGE(PG8_SB(1, 1), cB + hstepB + kstep, voffB);
        PG8_WAIT_V(6); PG8_BAR;
    } else {
        PG8_STAGE(PG8_SB(0, 0), cB, voffB); PG8_STAGE(PG8_SA(0, 0), cA, voffA); PG8_STAGE(PG8_SB(0, 1), cB + hstepB, voffB); PG8_STAGE(PG8_SA(0, 1), cA + hstepA, voffA);
        if (wr == 1) PG8_BAR;
        PG8_WAIT_V(4); PG8_BAR;
        PG8_STAGE(PG8_SB(1, 0), cB + kstep, voffB); PG8_STAGE(PG8_SA(1, 0), cA + kstep, voffA); PG8_STAGE(PG8_SB(1, 1), cB + hstepB + kstep, voffB);
        PG8_WAIT_V(6); PG8_BAR;
    }
    for (;;) {
        const bool has_next = S.next(ui + 1, nxt);
        const char* nA = has_next ? (const char*)g.A + (size_t)nxt.pm * tstepA : cA; const char* nB = has_next ? (const char*)g.Bt + (size_t)nxt.pn * tstepB + (size_t)(nxt.pm / g.mtpg) * g.bgs : cB;
#pragma unroll 1
        for (int t = 0; t < nt; t += 2) {
            const bool last = (t == nt - 2);
            const char* a1 = cA + (size_t)(t + 1) * kstep;
            const char* a2 = last ? nA : cA + (size_t)(t + 2) * kstep; const char* b2 = last ? nB : cB + (size_t)(t + 2) * kstep;
            const char* a3 = a2 + kstep; const char* b3 = b2 + kstep;
            if (last && has_next) S.a_ready(nxt);
            if constexpr (SP2) {
            PG8_LDB(B0, 0, 0); PG8_LDB(B1, 0, 1); PG8_SCHED; PG8_LDA(At, 0, 0); PG8_STAGE(PG8_SA(1, 1), a1 + hstepA, voffA);
            PG8_WAIT_V(8); PG8_WAIT_L(0); PG8_BAR; PG8_MMA(0, 0, At, B0); PG8_MMA(0, 1, At, B1); PG8_BAR; PG8_SCHED;
            PG8_LDA(At, 0, 1); PG8_STAGE(PG8_SB(0, 0), b2, voffB); PG8_STAGE(PG8_SB(0, 1), b2 + hstepB, voffB); PG8_STAGE(PG8_SA(0, 0), a2, voffA);
            PG8_WAIT_V(8); PG8_WAIT_L(0); PG8_BAR; PG8_MMA(1, 0, At, B0); PG8_MMA(1, 1, At, B1); PG8_BAR; PG8_SCHED;
            PG8_LDB(B0, 1, 0); PG8_LDB(B1, 1, 1); PG8_SCHED; PG8_LDA(At, 1, 0); PG8_STAGE(PG8_SA(0, 1), a2 + hstepA, voffA);
            PG8_WAIT_V(8); PG8_WAIT_L(0); PG8_BAR; PG8_MMA(0, 0, At, B0); PG8_MMA(0, 1, At, B1); PG8_BAR; PG8_SCHED;
            PG8_LDA(At, 1, 1); PG8_STAGE(PG8_SB(1, 0), b3, voffB); PG8_STAGE(PG8_SB(1, 1), b3 + hstepB, voffB); PG8_STAGE(PG8_SA(1, 0), a3, voffA);
            PG8_WAIT_V(8); PG8_WAIT_L(0); PG8_BAR; PG8_MMA(1, 0, At, B0); PG8_MMA(1, 1, At, B1); PG8_BAR; PG8_SCHED;
            } else {
            PG8_LDB(B0, 0, 0); PG8_SCHED; PG8_LDA(At, 0, 0); PG8_STAGE(PG8_SA(1, 1), a1 + hstepA, voffA);
            PG8_WAIT_L(8); PG8_BAR; PG8_WAIT_L(0); PG8_MMA(0, 0, At, B0); PG8_BAR; PG8_SCHED;
            PG8_LDB(B1, 0, 1); PG8_STAGE(PG8_SB(0, 0), b2, voffB);
            PG8_BAR; PG8_WAIT_L(0); PG8_MMA(0, 1, At, B1); PG8_BAR;
            PG8_LDA(At, 0, 1); PG8_STAGE(PG8_SA(0, 0), a2, voffA);
            PG8_BAR; PG8_WAIT_L(0); PG8_MMA(1, 0, At, B0); PG8_BAR; PG8_SCHED;
            PG8_STAGE(PG8_SB(0, 1), b2 + hstepB, voffB);
            PG8_WAIT_V(6); PG8_BAR; PG8_MMA(1, 1, At, B1); PG8_BAR;
            PG8_LDB(B0, 1, 0); PG8_SCHED; PG8_LDA(At, 1, 0); PG8_STAGE(PG8_SA(0, 1), a2 + hstepA, voffA);
            PG8_WAIT_L(8); PG8_BAR; PG8_WAIT_L(0); PG8_MMA(0, 0, At, B0); PG8_BAR; PG8_SCHED;
            PG8_LDB(B1, 1, 1); PG8_STAGE(PG8_SB(1, 0), b3, voffB);
            PG8_BAR; PG8_WAIT_L(0); PG8_MMA(0, 1, At, B1); PG8_BAR;
            PG8_LDA(At, 1, 1); PG8_STAGE(PG8_SA(1, 0), a3, voffA);
            PG8_BAR; PG8_WAIT_L(0); PG8_MMA(1, 0, At, B0); PG8_BAR; PG8_SCHED;
            PG8_STAGE(PG8_SB(1, 1), b3 + hstepB, voffB);
            PG8_WAIT_V(6); PG8_BAR; PG8_MMA(1, 1, At, B1); PG8_BAR;
            }
        }
        if constexpr (ALIGN_EPI) { if (wr == 0) PG8_BAR; }
        if constexpr (!Epi::AFTER_DRAIN) { E(acc, cur, wr, wc, fr, fq); S.done(cur); }
        if (!has_next) break;
#pragma unroll
        for (int a = 0; a < 2; ++a)
#pragma unroll
            for (int b = 0; b < 2; ++b)
#pragma unroll
                for (int m = 0; m < 4; ++m)
#pragma unroll
                    for (int n = 0; n < 2; ++n) acc[a][b][m][n] = (f32x4){0.f, 0.f, 0.f, 0.f};
        cur = nxt; cA = nA; cB = nB; ++ui;
        if constexpr (ALIGN_EPI) { if (wr == 1) PG8_BAR; }
    }
    PG8_WAIT_V(0);
    if constexpr (!ALIGN_EPI) { if (wr == 0) PG8_BAR; }
    PG8_BAR;
    if constexpr (Epi::AFTER_DRAIN) { E.fused(acc, cur, wr, wc, fr, fq, lds, wid, lane); S.done(cur); }
#undef PG8_SA
#undef PG8_SB
#undef PG8_STAGE
#undef PG8_LDA
#undef PG8_LDB
#undef PG8_MMA
#undef PG8_WAIT_V
#undef PG8_WAIT_L
#undef PG8_BAR
#undef PG8_SCHED
}
}

using pg8::bf16_t; using pg8::bf16x8; using pg8::f32x4; using pg8::u32x4;
typedef float f32x2 __attribute__((ext_vector_type(2)));
typedef unsigned u32x2 __attribute__((ext_vector_type(2)));
typedef short s16x4 __attribute__((ext_vector_type(4)));
typedef short v4i16_t __attribute__((ext_vector_type(4)));
#define LAS __attribute__((address_space(3)))
constexpr int NWAVES = 8, NTHREADS = 512;
constexpr int T = 32768, D = 1024, L = 8192, NB = 4, FF = 2816, INW = 4864, NH = 12;
constexpr float EPS = 1e-6f;
constexpr int LDS_BYTES = 147456;
constexpr int N_PHASES = 13;

constexpr size_t MiB = 1u << 20, KiB = 1u << 10;
constexpr size_t WS_SS1 = 0, WS_SS2 = 128 * KiB, WS_SS3 = 256 * KiB, WS_SSD = 384 * KiB;
constexpr size_t WS_BBAR = 576 * KiB;
constexpr size_t WS_LUT = 832 * KiB;
constexpr size_t WS_BAR = 848 * KiB;
constexpr size_t WS_APOW = 896 * KiB;
constexpr size_t WS_WGU1 = 2 * MiB, WS_WD1 = 13 * MiB, WS_WIN = WS_WD1 + 5632 * KiB, WS_WA = WS_WIN + 9728 * KiB, WS_WGLU = WS_WA + 512 * KiB,
                 WS_WS = WS_WGLU + 1 * MiB, WS_WOUT = WS_WS + 1 * MiB, WS_WGU2 = WS_WOUT + 2 * MiB, WS_WD2 = WS_WGU2 + 11 * MiB, WS_WEND = WS_WD2 + 5632 * KiB;
static_assert(WS_WEND <= 50 * MiB && WS_APOW + 32 * 64 * 66 * 4 <= 2 * MiB, "weights / control region");
constexpr size_t WS_XB = 50 * MiB;
constexpr size_t WS_OC = WS_XB, WS_YG = WS_XB + 16 * MiB, WS_X = WS_XB + 48 * MiB;
constexpr size_t WS_RA = 114 * MiB;
constexpr size_t WS_A1 = WS_RA, WS_Q = WS_RA, WS_K = WS_RA + 48 * MiB, WS_VT = WS_RA + 96 * MiB, WS_BTX = WS_RA + 144 * MiB, WS_BTY = WS_RA + 152 * MiB;
constexpr size_t WS_M1 = WS_RA, WS_YS = WS_RA + 64 * MiB, WS_MG = WS_RA + 96 * MiB;
constexpr size_t WS_G = 290 * MiB;
constexpr size_t WS_OG = 418 * MiB, WS_LSE = 466 * MiB, WS_AY = 468 * MiB, WS_END = 508 * MiB;
constexpr int CN = 32, AYP = 640;
constexpr size_t BAR_ZERO_BYTES = 16 * KiB;
#define XB_TMO      128
#define XB_XCNT(j)  (256  + 64 * (j))
#define XB_XSUB(j)  (1280 + 64 * (j))
#define XB_XGEN(j)  (2304 + 64 * (j))
#define XB_TOP      3328
#define XB_TOPGEN   3392
#define XCD_BAR_WORDS 3456
#define XB_SPIN_CAP (1u << 18)

__device__ __forceinline__ unsigned xb_ld(unsigned* p)              { return __hip_atomic_load(p, __ATOMIC_RELAXED, __HIP_MEMORY_SCOPE_AGENT); }
__device__ __forceinline__ unsigned xb_add(unsigned* p, unsigned v) { return __hip_atomic_fetch_add(p, v, __ATOMIC_RELAXED, __HIP_MEMORY_SCOPE_AGENT); }
__device__ __forceinline__ unsigned xb_xcc_id() { return (unsigned)__builtin_amdgcn_s_getreg((3 << 11) | 20) & 0xFu; }
#define XB_SPIN(cond, bar) do { unsigned _sp = 0; while (cond) { __builtin_amdgcn_s_sleep(1); \
    if ((++_sp & 255u) == 0u) { if (xb_ld(&(bar)[XB_TMO])) break; if (_sp > XB_SPIN_CAP) { atomicAdd(&(bar)[XB_TMO], 1u); break; } } } } while (0)

struct XcdBarrier {
    unsigned* bar; unsigned x;
    volatile LAS unsigned* st;
};

__device__ __forceinline__ XcdBarrier xcd_barrier_post(unsigned* bar, volatile LAS unsigned* st) {
    XcdBarrier b; b.bar = bar; b.x = xb_xcc_id(); b.st = st;
    if (threadIdx.x == 0) (void)xb_add(&bar[XB_XCNT(b.x)], 1u);
    return b;
}
__device__ __forceinline__ void xcd_barrier_complete(unsigned* bar, unsigned x, unsigned& nloc, unsigned& nx) {
    const unsigned G = gridDim.x * gridDim.y * gridDim.z;
    unsigned sum, cnt, mine, sp = 0u;
    for (;;) {
        sum = 0u; cnt = 0u; mine = 0u;
#pragma unroll
        for (unsigned j = 0; j < 16; ++j) { const unsigned c = xb_ld(&bar[XB_XCNT(j)]); sum += c; cnt += (c > 0u) ? 1u : 0u; mine = (j == x) ? c : mine; }
        if (sum == G) break;
        __builtin_amdgcn_s_sleep(1);
        if ((++sp & 255u) == 0u) { if (xb_ld(&bar[XB_TMO])) break; if (sp > XB_SPIN_CAP) { atomicAdd(&bar[XB_TMO], 1u); break; } }
    }
    nloc = mine > 0u ? mine : 1u; nx = cnt > 0u ? cnt : 1u;
}

__device__ __forceinline__ void xcd_barrier(const XcdBarrier& b) {
    asm volatile("s_waitcnt vmcnt(0)" ::: "memory");
    __syncthreads();
    if (threadIdx.x == 0) {
        unsigned* bar = b.bar;
        __builtin_amdgcn_s_waitcnt(0);
        unsigned nloc = b.st[0], nx = b.st[1];
        if (nloc == 0u) { xcd_barrier_complete(bar, b.x, nloc, nx); b.st[0] = nloc; b.st[1] = nx; }
        const unsigned old = xb_add(&bar[XB_XSUB(b.x)], 1u);
        const unsigned gen = old / nloc;
        if (old + 1u == (gen + 1u) * nloc) {
            __builtin_amdgcn_fence(__ATOMIC_RELEASE, "agent");
            asm volatile("s_waitcnt vmcnt(0)" ::: "memory");
            const unsigned og = xb_add(&bar[XB_TOP], 1u);
            const unsigned tg = og / nx;
            if (og + 1u == (tg + 1u) * nx) xb_add(&bar[XB_TOPGEN], 1u);
            else XB_SPIN(xb_ld(&bar[XB_TOPGEN]) == tg, bar);
            __builtin_amdgcn_fence(__ATOMIC_ACQUIRE, "agent");
            xb_add(&bar[XB_XGEN(b.x)], 1u);
            asm volatile("s_waitcnt vmcnt(0)" ::: "memory");
        } else {
            XB_SPIN(xb_ld(&bar[XB_XGEN(b.x)]) == gen, bar);
            __builtin_amdgcn_fence(__ATOMIC_ACQUIRE, "agent");
            asm volatile("s_waitcnt vmcnt(0)" ::: "memory");
        }
    }
    __syncthreads();
}

struct Params { const float* in[26]; float* out; unsigned char* ws; int ph_lo, ph_hi; unsigned char bk[3][136]; };

__device__ __forceinline__ float wave_sum(float v) {
#pragma unroll
    for (int o = 1; o < 64; o <<= 1) v += __shfl_xor(v, o);
    return v;
}
__device__ __forceinline__ unsigned f2bf(float f) { unsigned u = __builtin_bit_cast(unsigned, f); return (u + 0x7fffu + ((u >> 16) & 1u)) >> 16; }
__device__ __forceinline__ unsigned pk2(float lo, float hi) { return f2bf(lo) | (f2bf(hi) << 16); }
#define LDS_WAIT() asm volatile("s_waitcnt lgkmcnt(0)" ::: "memory")

__device__ __forceinline__ void transpose_item(const float* W, int K, int N, bf16_t* WT, int k0, int n0, int rowbase, const float* gain, LAS float* scr, int lane) {
    f32x4 v[8];
    const int kq = lane >> 3, n4 = (lane & 7) * 4;
#pragma unroll
    for (int i = 0; i < 8; ++i) v[i] = *(const f32x4*)(W + (size_t)(k0 + kq + 8 * i) * N + n0 + n4);
#pragma unroll
    for (int i = 0; i < 8; ++i) { const int kk = kq + 8 * i; const float gk = gain ? gain[k0 + kk] : 1.0f;
        scr[kk * 33 + n4 + 0] = v[i][0] * gk; scr[kk * 33 + n4 + 1] = v[i][1] * gk; scr[kk * 33 + n4 + 2] = v[i][2] * gk; scr[kk * 33 + n4 + 3] = v[i][3] * gk; }
    LDS_WAIT();
    const int c = lane & 7;
#pragma unroll
    for (int j = 0; j < 4; ++j) { const int n = (lane >> 3) + 8 * j; const LAS float* s = scr + (8 * c) * 33 + n;
        u32x4 o; o.x = pk2(s[0 * 33], s[1 * 33]); o.y = pk2(s[2 * 33], s[3 * 33]); o.z = pk2(s[4 * 33], s[5 * 33]); o.w = pk2(s[6 * 33], s[7 * 33]);
        *(u32x4*)(WT + (size_t)(rowbase + n) * K + k0 + 8 * c) = o; }
    LDS_WAIT();
}
__device__ __forceinline__ int tdesc_row(int mode, int N, int n0) {
    if (mode == 0) return n0;
    if (mode == 1) return (n0 >> 7) * 256 + (n0 & 127);
    if (mode == 2) return (n0 >> 7) * 256 + 128 + (n0 & 127);
    const int half = N >> 1; const int j = n0 < half ? n0 : n0 - half; return (j >> 7) * 256 + (n0 < half ? 0 : 128) + (j & 127);
}

__device__ __forceinline__ float gelu_tanh(float x) {
    const float u = 0.7978845608028654f * (x + 0.044715f * x * x * x);
    const float e = __expf(2.f * u);
    const float th = 1.f - 2.f * __builtin_amdgcn_rcpf(e + 1.f);
    return 0.5f * x * (1.f + th);
}

__device__ __forceinline__ pg8::Gemm mk_gemm(const bf16_t* A, const bf16_t* Bt, int M, int N, int K) { return pg8::Gemm{A, Bt, M, N, K, K, K, 1 << 30, (size_t)0}; }

__global__ void __launch_bounds__(NTHREADS, 2) fwd_kernel(Params P) {
    extern __shared__ __attribute__((aligned(16))) unsigned char lds_raw[];
    LAS unsigned char* lds = (LAS unsigned char*)lds_raw;
    const int tid = threadIdx.x, lane = tid & 63, wave = __builtin_amdgcn_readfirstlane(tid >> 6);
    const int G = gridDim.x, bid = blockIdx.x;
    const int gw = bid * NWAVES + wave, NGW = G * NWAVES;
    unsigned char* ws = P.ws;
    float* ss1 = (float*)(ws + WS_SS1); float* ss2 = (float*)(ws + WS_SS2); float* ss3 = (float*)(ws + WS_SS3);
    float* bbar = (float*)(ws + WS_BBAR); float* lutg = (float*)(ws + WS_LUT); float* apow = (float*)(ws + WS_APOW);
    bf16_t* Wgu1 = (bf16_t*)(ws + WS_WGU1); bf16_t* Wd1 = (bf16_t*)(ws + WS_WD1); bf16_t* Win = (bf16_t*)(ws + WS_WIN); bf16_t* Wa = (bf16_t*)(ws + WS_WA);
    bf16_t* Wglu = (bf16_t*)(ws + WS_WGLU); bf16_t* Wsb = (bf16_t*)(ws + WS_WS); bf16_t* Wout = (bf16_t*)(ws + WS_WOUT); bf16_t* Wgu2 = (bf16_t*)(ws + WS_WGU2); bf16_t* Wd2 = (bf16_t*)(ws + WS_WD2);
    bf16_t* XB = (bf16_t*)(ws + WS_XB); bf16_t* Oc = (bf16_t*)(ws + WS_OC); bf16_t* Yg = (bf16_t*)(ws + WS_YG); float* Xs = (float*)(ws + WS_X);
    bf16_t* A1 = (bf16_t*)(ws + WS_A1); bf16_t* Qp = (bf16_t*)(ws + WS_Q); bf16_t* Kp = (bf16_t*)(ws + WS_K); bf16_t* Vtp = (bf16_t*)(ws + WS_VT);
    bf16_t* BtX = (bf16_t*)(ws + WS_BTX); bf16_t* BtY = (bf16_t*)(ws + WS_BTY); bf16_t* AY = (bf16_t*)(ws + WS_AY);
    bf16_t* M1 = (bf16_t*)(ws + WS_M1); bf16_t* Ys = (bf16_t*)(ws + WS_YS); bf16_t* MG = (bf16_t*)(ws + WS_MG);
    bf16_t* Gt = (bf16_t*)(ws + WS_G); bf16_t* Og = (bf16_t*)(ws + WS_OG); float* LSE = (float*)(ws + WS_LSE);
    const float* x = P.in[0];
    float* dumF = (float*)(ws + WS_G); bf16_t* dumB = (bf16_t*)(ws + WS_M1); float* ssd = (float*)(ws + WS_SSD);
    float* out = P.out;
    const int lo = P.ph_lo, hi = P.ph_hi;
    volatile LAS unsigned* misc = (volatile LAS unsigned*)(lds + 131072 + 64);
    if (tid < 2) misc[tid] = 0u;
    __syncthreads();
    XcdBarrier bar; bar.bar = (unsigned*)(ws + WS_BAR); bar.x = 0; bar.st = nullptr;
    if (hi - lo > 1) bar = xcd_barrier_post((unsigned*)(ws + WS_BAR), misc);
#ifndef REPEAT_PH
#define REPEAT_PH (-1)
#endif
#ifndef REPEAT_N
#define REPEAT_N 1
#endif
#define REPS(k) (((k) == REPEAT_PH) ? 1 + REPEAT_N : 1)
#ifndef PHMASK
#define PHMASK 0xFFFF
#endif
#define IN_PH(k) ((((PHMASK) >> (k)) & 1) && lo <= (k) && (k) < hi)
#define SEAM(k) do { if (IN_PH(k) && IN_PH((k) + 1)) { xcd_barrier(bar); } } while (0)
    if (lo < 0) cg::this_grid().sync();

    if (IN_PH(0)) for (int rep = 0; rep < REPS(0); ++rep) {
        LAS float* scr = (LAS float*)(lds + wave * 16384);
        int itbase = 0;
#define DO_MAT(Wp, Kd, Nd, WTp, MODE, GAIN) do { const int nblk = (Nd) / 32, nit = ((Kd) / 64) * nblk; const int first = (gw - (itbase % NGW) + NGW) % NGW; \
            for (int it = first; it < nit; it += NGW) { const int kb = it / nblk, nb = it % nblk; transpose_item((Wp), (Kd), (Nd), (WTp), 64 * kb, 32 * nb, tdesc_row((MODE), (Nd), 32 * nb), (GAIN), scr, lane); } \
            itbase += nit; } while (0)
        DO_MAT(P.in[2], D, FF, Wgu1, 1, (const float*)nullptr); DO_MAT(P.in[3], D, FF, Wgu1, 2, (const float*)nullptr); DO_MAT(P.in[4], FF, D, Wd1, 0, (const float*)nullptr);
        DO_MAT(P.in[6], D, INW, Win, 0, P.in[5]); DO_MAT(P.in[18], 256, D, Wa, 0, (const float*)nullptr); DO_MAT(P.in[17], 512, D, Wglu, 3, (const float*)nullptr);
        DO_MAT(P.in[19], 512, D, Wsb, 0, (const float*)nullptr); DO_MAT(P.in[20], D, D, Wout, 0, (const float*)nullptr);
        DO_MAT(P.in[22], D, FF, Wgu2, 1, P.in[21]); DO_MAT(P.in[23], D, FF, Wgu2, 2, P.in[21]); DO_MAT(P.in[24], FF, D, Wd2, 0, (const float*)nullptr);
#undef DO_MAT
        { const float* g1 = P.in[1];
          f32x4 gg[4];
#pragma unroll
          for (int j = 0; j < 4; ++j) gg[j] = ((const f32x4*)g1)[lane + 64 * j];
          for (int r = gw; r < T; r += 2 * NGW) {
            const int r2 = r + NGW; const bool has2 = r2 < T;
            const f32x4* xa = (const f32x4*)(x + (size_t)r * D) + lane; const f32x4* xb_ = (const f32x4*)(x + (size_t)(has2 ? r2 : r) * D) + lane;
            f32x4 va[4], vb[4]; float sa = 0.f, sb = 0.f;
#pragma unroll
            for (int j = 0; j < 4; ++j) { va[j] = xa[64 * j]; vb[j] = xb_[64 * j]; }
#pragma unroll
            for (int j = 0; j < 4; ++j) { sa += (va[j][0] * va[j][0] + va[j][1] * va[j][1]) + (va[j][2] * va[j][2] + va[j][3] * va[j][3]); sb += (vb[j][0] * vb[j][0] + vb[j][1] * vb[j][1]) + (vb[j][2] * vb[j][2] + vb[j][3] * vb[j][3]); }
            const float ra = 1.0f / sqrtf(wave_sum(sa) * (1.0f / D) + EPS), rb = 1.0f / sqrtf(wave_sum(sb) * (1.0f / D) + EPS);
            u32x2* oa = (u32x2*)(XB + (size_t)r * D) + lane; u32x2* ob = (u32x2*)(XB + (size_t)r2 * D) + lane;
#pragma unroll
            for (int j = 0; j < 4; ++j) { u32x2 w; w.x = pk2(va[j][0] * ra * gg[j][0], va[j][1] * ra * gg[j][1]); w.y = pk2(va[j][2] * ra * gg[j][2], va[j][3] * ra * gg[j][3]); oa[64 * j] = w; }
            if (has2) {
#pragma unroll
              for (int j = 0; j < 4; ++j) { u32x2 w; w.x = pk2(vb[j][0] * rb * gg[j][0], vb[j][1] * rb * gg[j][1]); w.y = pk2(vb[j][2] * rb * gg[j][2], vb[j][3] * rb * gg[j][3]); ob[64 * j] = w; }
            }
          } }
        for (int i = bid * NTHREADS + tid; i < 3 * T; i += G * NTHREADS) ((float*)(ws + WS_SS1))[i] = 0.f;
        for (int i = bid * NTHREADS + tid; i < 32 * 64 * 33; i += G * NTHREADS) {
            const int gn = i / 33, p = i - gn * 33, g = gn >> 6;
            const float dt = expf(P.in[11][g]), zr = P.in[9][gn] * dt * (float)p, zi = P.in[10][gn] * dt * (float)p, mp = expf(zr);
            apow[(size_t)gn * 66 + 2 * p] = mp * cosf(zi); apow[(size_t)gn * 66 + 2 * p + 1] = mp * sinf(zi);
        }
        for (int i = bid * NTHREADS + tid; i < 32 * 64; i += G * NTHREADS) {
            const int g = i >> 6;
            const float dt = expf(P.in[11][g]), lre = P.in[9][i], lim = P.in[10][i];
            const float zr = lre * dt, zi = lim * dt, em1 = expm1f(zr), mag = em1 + 1.0f, cz = cosf(zi), sz = sinf(zi), sh = sinf(0.5f * zi);
            const float abim = mag * sz;
            const float xr = em1 * cz - 2.0f * sh * sh;
            const float den = lre * lre + lim * lim;
            const float cre = (xr * lre + abim * lim) / den, cim = (abim * lre - xr * lim) / den;
            for (int c = 0; c < 16; ++c) { const float br = P.in[12][i * 16 + c], bi = P.in[13][i * 16 + c];
                bbar[i * 32 + c] = cre * br - cim * bi; bbar[i * 32 + 16 + c] = cre * bi + cim * br; }
        }
        for (int i = bid * NTHREADS + tid; i < 12 * 132; i += G * NTHREADS) { const int h = i / 132, s = i % 132; lutg[i] = (s <= 128) ? P.in[8][(int)P.bk[h >> 2][s] * 12 + h] : 0.f; }
    }
    SEAM(0);

    if (IN_PH(1)) for (int rep = 0; rep < REPS(1); ++rep) {
        const pg8::Gemm g = mk_gemm(XB, Wgu1, T, 2 * FF, D); pg8::StaticOrder S; S.init(T, 2 * FF, G, bid);
        pg8::EpiSwiglu E{A1, FF, nullptr};
        pg8::gemm_phase<pg8::EpiSwiglu, pg8::StaticOrder, true, true>(lds, g, S, E);
    }
    SEAM(1);
    if (IN_PH(2)) for (int rep = 0; rep < REPS(2); ++rep) {
        const pg8::Gemm g = mk_gemm(A1, Wd1, T, D, FF); pg8::StaticOrder S; S.init(T, D, G, bid);
        pg8::EpiResid E{x, rep ? dumF : out, XB, rep ? ssd : ss1, 0.5f};
        pg8::gemm_phase<pg8::EpiResid, pg8::StaticOrder, true, true>(lds, g, S, E);
    }
    SEAM(2);
    if (IN_PH(3)) for (int rep = 0; rep < REPS(3); ++rep) {
        const float* cre_g = P.in[14]; const float* cim_g = P.in[15]; const float* dsk = P.in[16];
        for (int i = bid * NTHREADS + tid; i < 32 * 64 * 32; i += G * NTHREADS) {
            const int ip = i & 31, gn = i >> 5, g = gn >> 6, n = gn & 63;
            const float wr_ = apow[(size_t)gn * 66 + 2 * (31 - ip)], wi_ = apow[(size_t)gn * 66 + 2 * (31 - ip) + 1];
            f32x4 br[4], bi[4];
#pragma unroll
            for (int q = 0; q < 4; ++q) { br[q] = *(const f32x4*)(bbar + gn * 32 + 4 * q); bi[q] = *(const f32x4*)(bbar + gn * 32 + 16 + 4 * q); }
            bf16_t* r0 = BtX + ((size_t)(g * 256 + 2 * n) * 512 + ip * 16);
            *(u32x4*)(r0) = pg8::pack8(br[0] * wr_ - bi[0] * wi_, br[1] * wr_ - bi[1] * wi_); *(u32x4*)(r0 + 8) = pg8::pack8(br[2] * wr_ - bi[2] * wi_, br[3] * wr_ - bi[3] * wi_);
            *(u32x4*)(r0 + 512) = pg8::pack8(bi[0] * wr_ + br[0] * wi_, bi[1] * wr_ + br[1] * wi_); *(u32x4*)(r0 + 512 + 8) = pg8::pack8(bi[2] * wr_ + br[2] * wi_, bi[3] * wr_ + br[3] * wi_);
        }
        for (int i = bid * NTHREADS + tid; i < 32 * 128 * 64; i += G * NTHREADS) { const int g = i >> 13, r = (i >> 6) & 127, c8 = i & 63; *(u32x4*)(BtX + ((size_t)(g * 256 + 128 + r) * 512 + c8 * 8)) = (u32x4){0u, 0u, 0u, 0u}; }
        for (int i = bid * NTHREADS + tid; i < 32 * 512 * 64; i += G * NTHREADS) {
            const int n = i & 63, row = (i >> 6) & 511, g = i >> 15, ii = row >> 4, co = row & 15;
            const float wr_ = apow[(size_t)(g * 64 + n) * 66 + 2 * (ii + 1)], wi_ = apow[(size_t)(g * 64 + n) * 66 + 2 * (ii + 1) + 1];
            const float cr = cre_g[(g * 16 + co) * 64 + n], ci = cim_g[(g * 16 + co) * 64 + n];
            *(unsigned*)(BtY + ((size_t)(g * 512 + row) * AYP + 512 + 2 * n)) = pg8::cvt_pk_bf16(cr * wr_ - ci * wi_, -(cr * wi_ + ci * wr_));
        }
        for (int it = gw; it < 32 * 63; it += NGW) {
            const int g = it / 63, tau = it - g * 63 - 31, ci = lane & 15, coq = lane >> 4;
            float kv[4] = {0.f, 0.f, 0.f, 0.f};
            if (tau >= 0) {
#pragma unroll 4
                for (int n = 0; n < 64; ++n) {
                    const int gn = g * 64 + n;
                    const float wr_ = apow[(size_t)gn * 66 + 2 * tau], wi_ = apow[(size_t)gn * 66 + 2 * tau + 1];
                    const float br = bbar[gn * 32 + ci], bi = bbar[gn * 32 + 16 + ci];
                    const float tr = wr_ * br - wi_ * bi, ti = wr_ * bi + wi_ * br;
#pragma unroll
                    for (int j = 0; j < 4; ++j) { const int co = coq + 4 * j; kv[j] += cre_g[(g * 16 + co) * 64 + n] * tr - cim_g[(g * 16 + co) * 64 + n] * ti; }
                }
                if (tau == 0) {
#pragma unroll
                    for (int j = 0; j < 4; ++j) if (coq + 4 * j == ci) kv[j] += dsk[16 * g + ci];
                }
            }
            const int at = tau < 0 ? -tau : tau;
#pragma unroll
            for (int j = 0; j < 4; ++j) {
                const bf16_t hv = (bf16_t)f2bf(kv[j]); const int co = coq + 4 * j;
                for (int q = 0; q < 32 - at; ++q) { const int ii = tau >= 0 ? q + tau : q, ip = tau >= 0 ? q : q + at; BtY[(size_t)(g * 512 + ii * 16 + co) * AYP + ip * 16 + ci] = hv; }
            }
        }
        const pg8::Gemm g = mk_gemm(XB, Win, T, INW, D); pg8::StaticOrder S; S.init(T, INW, G, bid);
        pg8::EpiZ E{Qp, AY, Gt, ss1, P.in[7]};
        pg8::gemm_phase<pg8::EpiZ, pg8::StaticOrder, true, true>(lds, g, S, E);
    }
    SEAM(3);
    if (IN_PH(4)) for (int rep = 0; rep < REPS(4); ++rep) {
        { const pg8::Gemm g{AY, BtX, T, 256, 512, AYP, 512, 4, (size_t)256 * 512 * 2}; pg8::StaticOrder S; S.init(T, 256, G, bid);
          pg8::EpiX E{Xs};
          pg8::gemm_phase<pg8::EpiX, pg8::StaticOrder, true, true>(lds, g, S, E); }
        __syncthreads();
        constexpr int AT_K = 6400, AT_V = AT_K + 32768;
        LAS float* lut = (LAS float*)lds;
        for (int i = tid; i < 12 * 132; i += NTHREADS) lut[i] = lutg[i];
        const int fr = lane & 15, fq = lane >> 4;
        constexpr int NU = NB * NH * 64;
        u32x4 kreg[4], vreg[4]; bf16x8 qreg[2];
#define AT_DECODE(bu_) const int bh = (bu_) >> 6, blk = (bu_) & 63, b = bh / NH, h = bh - b * NH, g = h >> 2, sh = 2 * g, lm = 13 - sh; \
        const int tq0 = blk * 128, r = tq0 >> lm, mb = tq0 & ((1 << lm) - 1); \
        const bf16_t* Hb = Qp + ((size_t)b * L + r) * 2304 + h * 64;
#define AT_ISSUE(bu_) do { AT_DECODE(bu_) (void)g; \
            _Pragma("unroll") for (int j = 0; j < 4; ++j) { const int c = tid + 512 * j, key = c >> 3, part = c & 7, mk = mb - 128 + key; \
                if (mk >= 0) { const bf16_t* rp = Hb + ((size_t)mk << sh) * 2304 + part * 8; kreg[j] = *(const u32x4*)(rp + 768); vreg[j] = *(const u32x4*)(rp + 1536); } \
                else { kreg[j] = (u32x4){0u, 0u, 0u, 0u}; vreg[j] = (u32x4){0u, 0u, 0u, 0u}; } } \
            _Pragma("unroll") for (int ks = 0; ks < 2; ++ks) qreg[ks] = *(const bf16x8*)(Hb + ((size_t)(mb + 16 * wave + fr) << sh) * 2304 + 32 * ks + 8 * fq); } while (0)
        int bu = bid;
        if (bu < NU) AT_ISSUE(bu);
        while (bu < NU) {
#pragma unroll
            for (int j = 0; j < 4; ++j) { const int c = tid + 512 * j, key = c >> 3, part = c & 7; *(LAS u32x4*)(lds + AT_K + key * 128 + ((part ^ (key & 7)) << 4)) = kreg[j]; }
#pragma unroll
            for (int j = 0; j < 4; ++j) { const int c = tid + 512 * j, key = c >> 3, part = c & 7; *(LAS u32x4*)(lds + AT_V + key * 128 + ((part ^ (key & 7)) << 4)) = vreg[j]; }
            const bf16x8 qf0 = qreg[0], qf1 = qreg[1];
            __syncthreads();
            const int nbu = bu + G;
            if (nbu < NU) AT_ISSUE(nbu);
            {
                AT_DECODE(bu) (void)Hb; (void)lm;
                const int m0 = mb + 16 * wave;
                const LAS float* luth = lut + h * 132;
                float s[9][4];
#pragma unroll
                for (int kt = 1; kt <= 9; ++kt) {
                    const int kb = m0 - 144 + 16 * kt, krel = 16 * wave - 16 + 16 * kt;
                    if (kb >= 0) {
                        const int row = krel + fr;
                        const bf16x8 k0 = *(const LAS bf16x8*)(lds + AT_K + row * 128 + ((fq ^ (row & 7)) << 4));
                        const bf16x8 k1 = *(const LAS bf16x8*)(lds + AT_K + row * 128 + (((fq + 4) ^ (row & 7)) << 4));
                        f32x4 a = (f32x4){0.f, 0.f, 0.f, 0.f};
                        a = __builtin_amdgcn_mfma_f32_16x16x32_bf16(k0, qf0, a, 0, 0, 0);
                        a = __builtin_amdgcn_mfma_f32_16x16x32_bf16(k1, qf1, a, 0, 0, 0);
#pragma unroll
                        for (int i = 0; i < 4; ++i) { const int st = (m0 + fr) - (kb + 4 * fq + i); const bool ok = (st >= 0) && (st <= 128);
                            const int sc = st < 0 ? 0 : (st > 128 ? 128 : st); s[kt - 1][i] = ok ? a[i] + luth[sc] : -1e30f; }
                    } else {
#pragma unroll
                        for (int i = 0; i < 4; ++i) s[kt - 1][i] = -1e30f;
                    }
                }
                float mx = -1e30f;
#pragma unroll
                for (int kt = 0; kt < 9; ++kt)
#pragma unroll
                    for (int i = 0; i < 4; ++i) mx = fmaxf(mx, s[kt][i]);
                mx = fmaxf(mx, __shfl_xor(mx, 16)); mx = fmaxf(mx, __shfl_xor(mx, 32));
                float lsum = 0.f;
#pragma unroll
                for (int kt = 0; kt < 9; ++kt)
#pragma unroll
                    for (int i = 0; i < 4; ++i) { s[kt][i] = __expf(s[kt][i] - mx); lsum += s[kt][i]; }
                lsum += __shfl_xor(lsum, 16); lsum += __shfl_xor(lsum, 32);
                f32x4 oacc[4];
#pragma unroll
                for (int dt = 0; dt < 4; ++dt) oacc[dt] = (f32x4){0.f, 0.f, 0.f, 0.f};
#pragma unroll
                for (int kp = 0; kp < 5; ++kp) {
                    const int kb0 = m0 - 144 + 32 * kp, kb1 = kb0 + 16, krel0 = 16 * wave - 16 + 32 * kp;
                    u32x4 pw;
                    if (kp == 0) { pw.x = 0u; pw.y = 0u; } else { pw.x = pg8::cvt_pk_bf16(s[2 * kp - 1][0], s[2 * kp - 1][1]); pw.y = pg8::cvt_pk_bf16(s[2 * kp - 1][2], s[2 * kp - 1][3]); }
                    pw.z = pg8::cvt_pk_bf16(s[2 * kp][0], s[2 * kp][1]); pw.w = pg8::cvt_pk_bf16(s[2 * kp][2], s[2 * kp][3]);
                    const bf16x8 pf = __builtin_bit_cast(bf16x8, pw);
                    if (kb1 >= 0) {
                        const int vrow = krel0 + 4 * fq + ((lane & 15) >> 2), pp = lane & 3;
#pragma unroll
                        for (int dt = 0; dt < 4; ++dt) {
                            const int ch = 2 * dt + (pp >> 1);
                            s16x4 lo4 = (s16x4){0, 0, 0, 0};
                            if (kp > 0 && kb0 >= 0) lo4 = __builtin_bit_cast(s16x4, __builtin_amdgcn_ds_read_tr16_b64_v4i16((LAS v4i16_t*)(lds + AT_V + vrow * 128 + ((ch ^ (vrow & 7)) << 4) + ((pp & 1) << 3))));
                            const int vrow1 = vrow + 16;
                            const s16x4 hi4 = __builtin_bit_cast(s16x4, __builtin_amdgcn_ds_read_tr16_b64_v4i16((LAS v4i16_t*)(lds + AT_V + vrow1 * 128 + ((ch ^ (vrow1 & 7)) << 4) + ((pp & 1) << 3))));
                            const bf16x8 vf = (bf16x8){lo4[0], lo4[1], lo4[2], lo4[3], hi4[0], hi4[1], hi4[2], hi4[3]};
                            oacc[dt] = __builtin_amdgcn_mfma_f32_16x16x32_bf16(vf, pf, oacc[dt], 0, 0, 0);
                        }
                    }
                }
                const float inv = 1.0f / lsum;
                const int tok = b * L + ((m0 + fr) << sh) + r;
                bf16_t* op = Og + ((size_t)g * T + tok) * 256 + (h & 3) * 64 + 4 * fq;
#pragma unroll
                for (int dt = 0; dt < 4; ++dt) { u32x2 w; w.x = pg8::cvt_pk_bf16(oacc[dt][0] * inv, oacc[dt][1] * inv); w.y = pg8::cvt_pk_bf16(oacc[dt][2] * inv, oacc[dt][3] * inv); *(u32x2*)(op + 16 * dt) = w; }
                if (fq == 0) LSE[((size_t)g * T + tok) * 4 + (h & 3)] = mx + __logf(lsum);
            }
            __syncthreads();
            bu = nbu;
        }
#undef AT_DECODE
#undef AT_ISSUE
        __syncthreads();
    }
    SEAM(4);
    if (IN_PH(5)) for (int rep = 0; rep < REPS(5); ++rep) {
        for (int item = bid; item < 128; item += G) {
            LAS float* ex = (LAS float*)lds;
            const int b = item >> 5, g = item & 31, gn = g * 64 + lane;
            const float a32r = apow[(size_t)gn * 66 + 64], a32i = apow[(size_t)gn * 66 + 65];
            const size_t R0 = (size_t)(g * 1024 + b * 256 + 32 * wave);
            f32x2 xv[32];
#pragma unroll
            for (int k = 0; k < 32; ++k) xv[k] = *(const f32x2*)(Xs + (R0 + k) * 128 + 2 * lane);
            float sre = 0.f, sim = 0.f;
#pragma unroll
            for (int k = 0; k < 32; ++k) { const float nr = a32r * sre - a32i * sim + xv[k][0], ni = a32r * sim + a32i * sre + xv[k][1]; sre = nr; sim = ni; }
            __syncthreads();
            ex[(wave * 64 + lane) * 2] = sre; ex[(wave * 64 + lane) * 2 + 1] = sim;
            float pr = a32r, pi = a32i;
#pragma unroll
            for (int q = 0; q < 5; ++q) { const float nr = pr * pr - pi * pi, ni = 2.f * pr * pi; pr = nr; pi = ni; }
            __syncthreads();
            sre = 0.f; sim = 0.f;
            for (int v = 0; v < wave; ++v) { const float er = ex[(v * 64 + lane) * 2], ei = ex[(v * 64 + lane) * 2 + 1]; const float nr = pr * sre - pi * sim + er, ni = pr * sim + pi * sre + ei; sre = nr; sim = ni; }
#pragma unroll
            for (int k = 0; k < 32; ++k) {
                *(unsigned*)(AY + (R0 + k) * AYP + 512 + 2 * lane) = pg8::cvt_pk_bf16(sre, sim);
                const float nr = a32r * sre - a32i * sim + xv[k][0], ni = a32r * sim + a32i * sre + xv[k][1]; sre = nr; sim = ni;
            }
        }
        for (int it = gw; it < T / 2; it += NGW) {
            const int tok = it * 2 + (lane >> 5), ch = lane & 31, j = ch >> 3;
            const float l0 = LSE[((size_t)0 * T + tok) * 4 + j], l1 = LSE[((size_t)1 * T + tok) * 4 + j], l2 = LSE[((size_t)2 * T + tok) * 4 + j];
            const float mx = fmaxf(l0, fmaxf(l1, l2)); const float e0 = __expf(l0 - mx), e1 = __expf(l1 - mx), e2 = __expf(l2 - mx); const float inv = 1.0f / (e0 + e1 + e2);
            f32x4 a0, a1, b0, b1, c0, c1;
            pg8::unpack8(*(const u32x4*)(Og + ((size_t)0 * T + tok) * 256 + 8 * ch), a0, a1);
            pg8::unpack8(*(const u32x4*)(Og + ((size_t)1 * T + tok) * 256 + 8 * ch), b0, b1);
            pg8::unpack8(*(const u32x4*)(Og + ((size_t)2 * T + tok) * 256 + 8 * ch), c0, c1);
            const float w0 = e0 * inv, w1 = e1 * inv, w2 = e2 * inv;
            *(u32x4*)(Oc + (size_t)tok * 256 + 8 * ch) = pg8::pack8(a0 * w0 + b0 * w1 + c0 * w2, a1 * w0 + b1 * w1 + c1 * w2);
        }
        __syncthreads();
    }
    SEAM(5);
    if (IN_PH(6)) for (int rep = 0; rep < REPS(6); ++rep) {
        { const pg8::Gemm g{AY, BtY, T, 512, AYP, AYP, AYP, 4, (size_t)512 * AYP * 2}; pg8::StaticOrder S; S.init(T, 512, G, bid);
          pg8::EpiY E{Yg};
          pg8::gemm_phase<pg8::EpiY, pg8::StaticOrder, true, true>(lds, g, S, E); }
        { const pg8::Gemm g = mk_gemm(Oc, Wa, T, D, 256); pg8::StaticOrder S; S.init(T, D, G, bid);
          pg8::EpiGateMul E{M1, Gt};
          pg8::gemm_phase<pg8::EpiGateMul, pg8::StaticOrder, true, true>(lds, g, S, E); }
    }
    SEAM(6);
    if (IN_PH(7)) for (int rep = 0; rep < REPS(7); ++rep) {
        const pg8::Gemm g = mk_gemm(Yg, Wglu, T, D, 512); pg8::StaticOrder S; S.init(T, D, G, bid);
        pg8::EpiGlu E{Ys};
        pg8::gemm_phase<pg8::EpiGlu, pg8::StaticOrder, true, true>(lds, g, S, E);
    }
    SEAM(7);
    if (IN_PH(8)) for (int rep = 0; rep < REPS(8); ++rep) {
        const pg8::Gemm g = mk_gemm(Ys, Wsb, T, D, 512); pg8::StaticOrder S; S.init(T, D, G, bid);
        pg8::EpiMerge E{MG, M1, Gt + 1024};
        pg8::gemm_phase<pg8::EpiMerge, pg8::StaticOrder, true, true>(lds, g, S, E);
    }
    SEAM(8);
    if (IN_PH(9)) for (int rep = 0; rep < REPS(9); ++rep) {
        const pg8::Gemm g = mk_gemm(MG, Wout, T, D, D); pg8::StaticOrder S; S.init(T, D, G, bid);
        pg8::EpiResid E{out, rep ? dumF : out, rep ? dumB : XB, rep ? ssd : ss2, 1.0f};
        pg8::gemm_phase<pg8::EpiResid, pg8::StaticOrder, true, true>(lds, g, S, E);
    }
    SEAM(9);
    if (IN_PH(10)) for (int rep = 0; rep < REPS(10); ++rep) {
        const pg8::Gemm g = mk_gemm(XB, Wgu2, T, 2 * FF, D); pg8::StaticOrder S; S.init(T, 2 * FF, G, bid);
        pg8::EpiSwiglu E{A1, FF, ss2};
        pg8::gemm_phase<pg8::EpiSwiglu, pg8::StaticOrder, true, true>(lds, g, S, E);
    }
    SEAM(10);
    if (IN_PH(11)) for (int rep = 0; rep < REPS(11); ++rep) {
        const pg8::Gemm g = mk_gemm(A1, Wd2, T, D, FF); pg8::StaticOrder S; S.init(T, D, G, bid);
        pg8::EpiResid E{out, rep ? dumF : out, nullptr, rep ? ssd : ss3, 0.5f};
        pg8::gemm_phase<pg8::EpiResid, pg8::StaticOrder, true, true>(lds, g, S, E);
    }
    SEAM(11);
    if (IN_PH(12)) for (int rep = 0; rep < REPS(12); ++rep) {
        const float* gf = P.in[25];
        for (int r = gw; r < T; r += NGW) {
            const float rinv = 1.0f / sqrtf(ss3[r] * (1.0f / D) + EPS);
            f32x4* xr = (f32x4*)(out + (size_t)r * D) + lane; f32x4* xw = (f32x4*)((rep ? dumF : out) + (size_t)r * D) + lane;
#pragma unroll
            for (int j = 0; j < 4; ++j) { const f32x4 gg = ((const f32x4*)gf)[lane + 64 * j]; xw[64 * j] = xr[64 * j] * rinv * gg; }
        }
    }
#undef IN_PH
#undef SEAM
}

extern "C" void kernel_launch(void* const* d_in, const int* in_sizes, int n_in, void* d_out, int out_size, void* d_ws, size_t ws_size, hipStream_t stream) {
    static int grid = 0;
    if (grid == 0) {
        if (n_in != 26 || ws_size < WS_END) { fprintf(stderr, "kernel_launch: expected 26 inputs and >= %zu bytes of workspace; got %d, %zu\n", (size_t)WS_END, n_in, ws_size); grid = -1; return; }
        int dev = 0, cus = 0, per_cu = 0;
        (void)hipGetDevice(&dev); (void)hipDeviceGetAttribute(&cus, hipDeviceAttributeMultiprocessorCount, dev);
        if (hipFuncSetAttribute((const void*)fwd_kernel, hipFuncAttributeMaxDynamicSharedMemorySize, LDS_BYTES) != hipSuccess) { fprintf(stderr, "kernel_launch: hipFuncSetAttribute failed\n"); grid = -1; return; }
        (void)hipOccupancyMaxActiveBlocksPerMultiprocessor(&per_cu, (const void*)fwd_kernel, NTHREADS, LDS_BYTES);
        if (per_cu < 1) { fprintf(stderr, "kernel_launch: occupancy query says %d blocks per CU\n", per_cu); per_cu = 1; }
        (void)hipGetLastError();
        grid = cus;
        fprintf(stderr, "kernel_launch: grid %d (CUs %d, occupancy %d per CU)\n", grid, cus, per_cu);
    }
    if (grid < 0) return;
    Params p{};
    for (int i = 0; i < 26; ++i) p.in[i] = (const float*)d_in[i];
    p.out = (float*)d_out; p.ws = (unsigned char*)d_ws;
    for (int g = 0; g < 3; ++g) { const int dil = g == 0 ? 1 : (g == 1 ? 4 : 16);
        for (int s = 0; s <= 128; ++s) { const int dist = s * dil; int bkt;
            if (dist < 16) bkt = dist; else { const float dd = (float)dist; int large = 16 + (int)(logf(dd / 16.0f) / (float)log(128.0) * 16.0f); if (large > 31) large = 31; bkt = large; }
            p.bk[g][s] = (unsigned char)bkt; } }
#if ONE_LAUNCH
    if (hipMemsetAsync((char*)d_ws + WS_BAR, 0, BAR_ZERO_BYTES, stream) != hipSuccess) { fprintf(stderr, "kernel_launch: memset failed\n"); return; }
    p.ph_lo = 0; p.ph_hi = N_PHASES;
    void* args[] = {&p};
    hipError_t e = hipLaunchCooperativeKernel((const void*)fwd_kernel, dim3(grid), dim3(NTHREADS), args, LDS_BYTES, stream);
    if (e != hipSuccess) fprintf(stderr, "cooperative launch failed: %s (grid %d)\n", hipGetErrorString(e), grid);
#else
    for (int ph = 0; ph < N_PHASES; ++ph) { p.ph_lo = ph; p.ph_hi = ph + 1; hipLaunchKernelGGL(fwd_kernel, dim3(grid), dim3(NTHREADS), LDS_BYTES, stream, p); }
#endif
}
```
